# Optimizing an MI355X kernel written in HIP

```python
import math
import jax, jax.numpy as jnp
from jax import lax
import numpy as np

D_MODEL = 1024
BATCH = 8
SEQ = 2048
DEPTH = 1

GRID_W = 64
CTX_LEN = 256
D_MIX = D_MODEL
F_WIDTH = D_MIX // 4
N_FGROUPS = 4
FGROUP_DIM = F_WIDTH // N_FGROUPS
SSD_WIDTH = D_MIX - F_WIDTH
SSD_HEAD_DIM = 64
SSD_HEADS = SSD_WIDTH // SSD_HEAD_DIM
SSD_GROUPS = 4
HEADS_PER_GROUP = SSD_HEADS // SSD_GROUPS
D_STATE = 128
BC_WIDTH = SSD_GROUPS * D_STATE
CONV_DIM = SSD_WIDTH + 2 * BC_WIDTH
D_CONV = 7
CHUNK = 128
XBC_OFF = F_WIDTH + SSD_WIDTH
IN_WIDTH = XBC_OFF + CONV_DIM + 2 * SSD_HEADS
D_FF = -(-8 * D_MODEL // (3 * 256)) * 256
N_MOD = 6
EPS = 1e-6

kernel_name = 'fourier_ssd_hybrid_prefix_block'


def rms_norm(x, g):
    xf = x.astype(jnp.float32)
    y = xf * lax.rsqrt(jnp.mean(xf * xf, axis=-1, keepdims=True) + EPS)
    return (y * g.astype(jnp.float32)).astype(x.dtype)


def modulate(h, shift, scale):
    return h * (1 + scale) + shift


def conv_rows(u, w, bias, rows, row_len):
    b, L, ch = u.shape
    half = D_CONV // 2
    up = jnp.pad(u.reshape(b, rows, row_len, ch), ((0, 0), (0, 0), (half, half), (0, 0)))
    out = bias
    for k in range(D_CONV):
        out = out + up[:, :, k:k + row_len, :] * w[:, k]
    return out.reshape(b, L, ch)


def fourier_mix(u):
    b, L, _ = u.shape
    ug = u.reshape(b, L, N_FGROUPS, FGROUP_DIM).astype(jnp.float32)
    yf = jnp.fft.fft2(ug, axes=(1, 3), norm='ortho').real
    return yf.reshape(b, L, F_WIDTH).astype(u.dtype)


def ssd_scan(xdt, dA, Bm, Cm, h0, with_output):
    b, L = xdt.shape[:2]
    nc = L // CHUNK
    xq = xdt.reshape(b, nc, CHUNK, SSD_GROUPS, HEADS_PER_GROUP, SSD_HEAD_DIM)
    aq = dA.reshape(b, nc, CHUNK, SSD_GROUPS, HEADS_PER_GROUP)
    Bq = Bm.reshape(b, nc, CHUNK, SSD_GROUPS, D_STATE)
    Cq = Cm.reshape(b, nc, CHUNK, SSD_GROUPS, D_STATE)
    a_cs = jnp.cumsum(aq, axis=2)
    a_end = a_cs[:, :, -1]
    st = jnp.einsum('bcsgn,bcsgr,bcsgrp->bcgrpn', Bq, jnp.exp(a_end[:, :, None] - a_cs), xq)

    def step(h, inp):
        s_c, a_c = inp
        return jnp.exp(a_c)[..., None, None] * h + s_c, h

    h_fin, h_in = lax.scan(step, h0, (jnp.moveaxis(st, 1, 0), jnp.moveaxis(a_end, 1, 0)))
    if not with_output:
        return None, h_fin
    h_in = jnp.moveaxis(h_in, 0, 1)
    seg = a_cs[:, :, :, None] - a_cs[:, :, None]
    lower = jnp.tril(jnp.ones((CHUNK, CHUNK), dtype=bool))[:, :, None, None]
    decay = jnp.exp(jnp.where(lower, seg, -jnp.inf))
    scores = jnp.einsum('bcqgn,bcsgn->bcqsg', Cq, Bq)
    y_diag = jnp.einsum('bcqsg,bcqsgr,bcsgrp->bcqgrp', scores, decay, xq)
    y_off = jnp.einsum('bcqgn,bcgrpn,bcqgr->bcqgrp', Cq, h_in, jnp.exp(a_cs))
    return (y_diag + y_off).reshape(b, L, SSD_HEADS, SSD_HEAD_DIM), h_fin


def ssd_direction(xs, Bm, Cm, dt_raw, dt_bias, a_log, h0, with_output):
    b, L, _ = xs.shape
    dt = jax.nn.softplus(dt_raw.astype(jnp.float32) + dt_bias.astype(jnp.float32))
    dA = dt * -jnp.exp(a_log.astype(jnp.float32))
    xdt = xs.reshape(b, L, SSD_HEADS, SSD_HEAD_DIM) * dt[..., None]
    return ssd_scan(xdt, dA, Bm.reshape(b, L, SSD_GROUPS, D_STATE),
                    Cm.reshape(b, L, SSD_GROUPS, D_STATE), h0, with_output)


def ssd_bidir(xs, Bm, Cm, dt_raw, dt_bias, a_log, h0_fwd, h0_bwd, with_output):
    flip = lambda t: jnp.flip(t, axis=1)
    y_f, h_f = ssd_direction(xs, Bm, Cm, dt_raw[..., :SSD_HEADS], dt_bias[0], a_log[0], h0_fwd, with_output)
    y_b, h_b = ssd_direction(flip(xs), flip(Bm), flip(Cm), flip(dt_raw[..., SSD_HEADS:]),
                             dt_bias[1], a_log[1], h0_bwd, with_output)
    y = y_f + flip(y_b) if with_output else None
    return y, h_f, h_b


def mixer_inputs(h, w_in, conv_w, conv_b, rows, row_len, full):
    p = h @ (w_in if full else w_in[:, XBC_OFF:])
    if full:
        u_f, z, rest = p[..., :F_WIDTH], p[..., F_WIDTH:XBC_OFF], p[..., XBC_OFF:]
    else:
        u_f, z, rest = None, None, p
    xbc = jax.nn.silu(conv_rows(rest[..., :CONV_DIM], conv_w, conv_b, rows, row_len))
    dt_raw = rest[..., CONV_DIM:]
    xs = xbc[..., :SSD_WIDTH]
    Bm = xbc[..., SSD_WIDTH:SSD_WIDTH + BC_WIDTH]
    Cm = xbc[..., SSD_WIDTH + BC_WIDTH:]
    return u_f, z, xs, Bm, Cm, dt_raw


def mixer_output(u_f, z, xs, y, d_skip, g_ssd, w_out):
    b, L, _ = xs.shape
    y = y + xs.reshape(b, L, SSD_HEADS, SSD_HEAD_DIM) * d_skip[:, None]
    y = y.reshape(b, L, SSD_WIDTH).astype(xs.dtype)
    y = rms_norm(y * jax.nn.silu(z), g_ssd)
    return jnp.concatenate([fourier_mix(u_f), y], axis=-1) @ w_out


def swiglu(h, w_gate, w_up, w_down):
    return (jax.nn.silu(h @ w_gate) * (h @ w_up)) @ w_down


def setup_inputs(seed: int = 0) -> dict:
    key = jax.random.key(seed)
    ks = jax.random.split(key, 24)
    nrm = lambda k, shape, fan_in: jax.random.normal(k, shape, jnp.float32) * fan_in ** -0.5
    gain = lambda k, n: 1.0 + 0.05 * jax.random.normal(k, (DEPTH, n), jnp.float32)
    dt0 = jnp.exp(jax.random.uniform(ks[10], (DEPTH, 2, SSD_HEADS), jnp.float32)
                  * (math.log(0.1) - math.log(0.001)) + math.log(0.001))
    return {
        'x': jax.random.normal(ks[0], (BATCH, SEQ, D_MODEL), jnp.float32),
        'c': jax.random.normal(ks[1], (BATCH, D_MODEL), jnp.float32),
        'ctx': jax.random.normal(ks[2], (BATCH, CTX_LEN, D_MODEL), jnp.float32),
        'c_ctx': jax.random.normal(ks[3], (D_MODEL,), jnp.float32),
        'w_ada': nrm(ks[4], (DEPTH, D_MODEL, N_MOD * D_MODEL), D_MODEL),
        'b_ada': 0.01 * jax.random.normal(ks[5], (DEPTH, N_MOD * D_MODEL), jnp.float32),
        'g_pre_mix': gain(ks[6], D_MODEL),
        'g_post_mix': gain(ks[7], D_MODEL),
        'g_pre_ffn': gain(ks[8], D_MODEL),
        'g_post_ffn': gain(ks[9], D_MODEL),
        'w_in': nrm(ks[11], (DEPTH, D_MODEL, IN_WIDTH), D_MODEL),
        'conv_w': nrm(ks[12], (DEPTH, CONV_DIM, D_CONV), D_CONV),
        'conv_b': 0.01 * jax.random.normal(ks[13], (DEPTH, CONV_DIM), jnp.float32),
        'dt_bias': dt0 + jnp.log(-jnp.expm1(-dt0)),
        'a_log': jnp.log(jax.random.uniform(ks[14], (DEPTH, 2, SSD_HEADS), jnp.float32, 1.0, 16.0)),
        'd_skip': 1.0 + 0.1 * jax.random.normal(ks[15], (DEPTH, SSD_HEADS), jnp.float32),
        'g_ssd': gain(ks[16], SSD_WIDTH),
        'w_out': nrm(ks[17], (DEPTH, D_MIX, D_MODEL), D_MIX),
        'w_gate': nrm(ks[18], (DEPTH, D_MODEL, D_FF), D_MODEL),
        'w_up': nrm(ks[19], (DEPTH, D_MODEL, D_FF), D_MODEL),
        'w_down': nrm(ks[20], (DEPTH, D_FF, D_MODEL), D_FF),
    }


def reference(x, c, ctx, c_ctx, w_ada, b_ada, g_pre_mix, g_post_mix, g_pre_ffn, g_post_ffn,
              w_in, conv_w, conv_b, dt_bias, a_log, d_skip, g_ssd, w_out, w_gate, w_up, w_down):
    b = x.shape[0]
    rows = x.shape[1] // GRID_W
    ctx_len = ctx.shape[1]
    h0 = jnp.zeros((b, SSD_GROUPS, HEADS_PER_GROUP, SSD_HEAD_DIM, D_STATE), jnp.float32)
    for l in range(DEPTH):
        keep_ctx = l + 1 < DEPTH
        mx = (jax.nn.silu(c) @ w_ada[l] + b_ada[l])[:, None, :]
        sm_x, cm_x, gm_x, sf_x, cf_x, gf_x = jnp.split(mx, N_MOD, axis=-1)
        mc = jax.nn.silu(c_ctx) @ w_ada[l] + b_ada[l]
        sm_c, cm_c, gm_c, sf_c, cf_c, gf_c = jnp.split(mc, N_MOD, axis=-1)

        hc = modulate(rms_norm(ctx, g_pre_mix[l]), sm_c, cm_c)
        uf_c, z_c, xs_c, B_c, C_c, dt_c = mixer_inputs(hc, w_in[l], conv_w[l], conv_b[l], 1, ctx_len, keep_ctx)
        y_c, hf_c, hb_c = ssd_bidir(xs_c, B_c, C_c, dt_c, dt_bias[l], a_log[l], h0, h0, keep_ctx)

        hx = modulate(rms_norm(x, g_pre_mix[l]), sm_x, cm_x)
        uf_x, z_x, xs_x, B_x, C_x, dt_x = mixer_inputs(hx, w_in[l], conv_w[l], conv_b[l], rows, GRID_W, True)
        y_x, _, _ = ssd_bidir(xs_x, B_x, C_x, dt_x, dt_bias[l], a_log[l], hf_c, hb_c, True)
        x = x + gm_x * rms_norm(mixer_output(uf_x, z_x, xs_x, y_x, d_skip[l], g_ssd[l], w_out[l]), g_post_mix[l])

        hx2 = modulate(rms_norm(x, g_pre_ffn[l]), sf_x, cf_x)
        x = x + gf_x * rms_norm(swiglu(hx2, w_gate[l], w_up[l], w_down[l]), g_post_ffn[l])

        if keep_ctx:
            out_c = mixer_output(uf_c, z_c, xs_c, y_c, d_skip[l], g_ssd[l], w_out[l])
            ctx = ctx + gm_c * rms_norm(out_c, g_post_mix[l])
            hc2 = modulate(rms_norm(ctx, g_pre_ffn[l]), sf_c, cf_c)
            ctx = ctx + gf_c * rms_norm(swiglu(hc2, w_gate[l], w_up[l], w_down[l]), g_post_ffn[l])
    return x
```

```cpp
#include <hip/hip_runtime.h>
#include <hip/hip_cooperative_groups.h>
#include <cstdio>
#include <cstdint>
namespace cg = cooperative_groups;

#ifndef MK_LAUNCHES
#define MK_LAUNCHES 1
#endif

#define LAS __attribute__((address_space(3)))
typedef unsigned short bf16_t;
typedef short bf16x8 __attribute__((ext_vector_type(8)));
typedef float f32x4 __attribute__((ext_vector_type(4)));
typedef unsigned u32x4 __attribute__((ext_vector_type(4)));
typedef unsigned u32x2 __attribute__((ext_vector_type(2)));
typedef LAS unsigned char* ldsp;

constexpr int NB = 8, SEQ = 2048, DM = 1024, CTXL = 256;
constexpr int MLAT = NB * SEQ;
constexpr int MCTX = NB * CTXL;
constexpr int MALL = MLAT + MCTX;
constexpr int INW = 2840, DFF = 2816;
constexpr int N1 = 3328;
constexpr float EPS = 1e-6f;
constexpr int NTHR = 512, NWAVE = 8;
constexpr int LDS_BYTES = 143360;

constexpr size_t MiB = 1u << 20;
constexpr size_t WS_MOD = 0, WS_DT = 1 * MiB, WS_SSQG = 3 * MiB, WS_SSQ1 = 3 * MiB + 256 * 1024, WS_SSQ2 = 4 * MiB + 256 * 1024,
                 WS_AEND = 5 * MiB + 256 * 1024, WS_AENDC = WS_AEND + 16384,
                 WS_W1T = 6 * MiB, WS_WOT = WS_W1T + 6 * MiB + 512 * 1024, WS_WGUT = WS_WOT + 2 * MiB, WS_WDT = WS_WGUT + 11 * MiB,
                 WS_T = 31 * MiB, WS_VT = 47 * MiB, WS_Z = 63 * MiB, WS_H = 87 * MiB, WS_XBC = 123 * MiB, WS_ST = 186 * MiB, WS_STC = 234 * MiB,
                 WS_ACAT = WS_H, WS_O1 = 47 * MiB, WS_G = 123 * MiB, WS_END = 240 * MiB;

struct Params { const float* in[21]; float* out; unsigned char* ws; };

typedef float f32x2_t __attribute__((ext_vector_type(2)));
typedef __bf16 bf16x2_t __attribute__((ext_vector_type(2)));
__device__ __forceinline__ unsigned pk2(float lo, float hi) { const f32x2_t v = {lo, hi}; return __builtin_bit_cast(unsigned, __builtin_convertvector(v, bf16x2_t)); }
__device__ __forceinline__ float bflo(unsigned w) { return __uint_as_float(w << 16); }
__device__ __forceinline__ float bfhi(unsigned w) { return __uint_as_float(w & 0xffff0000u); }
__device__ __forceinline__ float silu_f(float x) { return x * __builtin_amdgcn_rcpf(1.0f + __expf(-x)); }
__device__ __forceinline__ float wave_sum(float v) {
#pragma unroll
    for (int o = 1; o < 64; o <<= 1) v += __shfl_xor(v, o);
    return v;
}
#define LDS_WAIT() asm volatile("s_waitcnt lgkmcnt(0)" ::: "memory")

namespace pg8 {
constexpr int BM = 256, BK = 64, HALF = 128, HTB = HALF * BK * 2, NXCD = 8, WGM = 8;
__device__ __forceinline__ int lds_byte(int r, int c) { const int st = (r >> 4) * 2 + (c >> 5), rr = r & 15, cc = c & 31, ob = rr * 64 + cc * 2; return st * 1024 + (ob ^ (((ob >> 9) & 1) << 5)); }
__device__ __forceinline__ void stage_rc(int b, int& R, int& C) { const int st = b / 1024, sb = b % 1024, swz = sb ^ (((sb >> 9) & 1) << 5); R = (st >> 1) * 16 + swz / 64; C = (st & 1) * 32 + (swz % 64) / 2; }
__device__ __forceinline__ int perm32(int rho) { const int n = rho >> 4, i = rho & 15; return 8 * (i >> 2) + 4 * n + (i & 3); }

struct Unit { int pm, pn, ko; };
struct Gemm { const bf16_t* A; const bf16_t* Bt; int lda, ldb, K; };

struct StaticOrder {
    int nM, nN, nwg, G, c;
    __device__ void init(int M, int N, int G_, int c_) { nM = M / BM; nN = N / BM; nwg = nM * nN; G = G_; c = c_; }
    __device__ bool next(int i, Unit& u) const {
        const long L = (long)i * G + c; if (L >= nwg) return false;
        int wgid = (int)L; { const int q = nwg / NXCD, r = nwg % NXCD, xcd = wgid % NXCD, off = wgid / NXCD; wgid = (xcd < r ? xcd * (q + 1) : r * (q + 1) + (xcd - r) * q) + off; }
        const int nig = WGM * nN, gid = wgid / nig, fm = gid * WGM, gsz = (nM - fm) < WGM ? (nM - fm) : WGM;
        u.pm = fm + ((wgid % nig) % gsz); u.pn = (wgid % nig) / gsz; u.ko = 0; return true;
    }
};
struct SplitKOrder {
    int G, c;
    __device__ bool next(int i, Unit& u) const {
        const int L = i * G + c; if (L >= 256) return false;
        u.ko = (L >> 6) * 1024; u.pm = (L >> 3) & 7; u.pn = L & 7; return true;
    }
};

template <class Epi, class Sched>
__device__ __forceinline__ void gemm_phase(ldsp lds, const Gemm g, const Sched& S, const Epi& E) {
    const int tid = threadIdx.x, wid = __builtin_amdgcn_readfirstlane(tid >> 6), lane = tid & 63, wr = wid >> 2, wc = wid & 3, fr = lane & 15, fq = lane >> 4;
    const int nt = g.K / BK;
    unsigned voffA[2], voffB[2];
#pragma unroll
    for (int i = 0; i < 2; ++i) { int R, C; stage_rc(tid * 16 + i * 8192, R, C); const int Rb = Epi::PERM ? ((R & ~31) + perm32(R & 31)) : R;
        voffA[i] = (unsigned)(R * g.lda + C) * 2u; voffB[i] = (unsigned)(Rb * g.ldb + C) * 2u; }
    const size_t kstep = (size_t)(BK * 2);
    const size_t hstepA = (size_t)HALF * g.lda * 2, hstepB = (size_t)HALF * g.ldb * 2, tstepA = 2 * hstepA, tstepB = 2 * hstepB;
    const unsigned ldsw = (unsigned)wid * 1024u;
    const int aoff = lds_byte(wr * 64 + fr, fq * 8), boff = lds_byte(wc * 32 + fr, fq * 8);
#define PG8_SA(b, h) (((b) * 2 + (h)) * HTB)
#define PG8_SB(b, h) ((4 + (b) * 2 + (h)) * HTB)
#define PG8_STAGE(bufoff, gbase, voff) do { _Pragma("unroll") for (int _i = 0; _i < 2; ++_i) \
        __builtin_amdgcn_global_load_lds((const unsigned*)((const char*)(gbase) + (voff)[_i]), (LAS unsigned*)(lds + (bufoff) + ldsw + _i * 8192), 16, 0, 0); } while (0)
#define PG8_LDA(dst, b, h) do { _Pragma("unroll") for (int m = 0; m < 4; ++m) _Pragma("unroll") for (int k = 0; k < 2; ++k) dst[m][k] = *(const LAS bf16x8*)(lds + PG8_SA(b, h) + aoff + m * 2048 + k * 1024); } while (0)
#define PG8_LDB(dst, b, h) do { _Pragma("unroll") for (int n = 0; n < 2; ++n) _Pragma("unroll") for (int k = 0; k < 2; ++k) dst[n][k] = *(const LAS bf16x8*)(lds + PG8_SB(b, h) + boff + n * 2048 + k * 1024); } while (0)
#define PG8_MMA(ai, bj, At, Bt) do { __builtin_amdgcn_s_setprio(1); _Pragma("unroll") for (int m = 0; m < 4; ++m) _Pragma("unroll") for (int n = 0; n < 2; ++n) _Pragma("unroll") for (int k = 0; k < 2; ++k) \
        acc[ai][bj][m][n] = __builtin_amdgcn_mfma_f32_16x16x32_bf16(Bt[n][k], At[m][k], acc[ai][bj][m][n], 0, 0, 0); __builtin_amdgcn_s_setprio(0); } while (0)
#define PG8_WAIT_V(n) asm volatile("s_waitcnt vmcnt(" #n ")" ::: "memory")
#define PG8_WAIT_L(n) asm volatile("s_waitcnt lgkmcnt(" #n ")" ::: "memory")
#define PG8_BAR __builtin_amdgcn_s_barrier()
#define PG8_SCHED __builtin_amdgcn_sched_barrier(0)
    Unit cur, nxt; int ui = 0;
    if (!S.next(0, cur)) return;
    f32x4 acc[2][2][4][2];
#pragma unroll
    for (int a = 0; a < 2; ++a)
#pragma unroll
        for (int b = 0; b < 2; ++b)
#pragma unroll
            for (int m = 0; m < 4; ++m)
#pragma unroll
                for (int n = 0; n < 2; ++n) acc[a][b][m][n] = (f32x4){0.f, 0.f, 0.f, 0.f};
    bf16x8 At[4][2], B0[2][2], B1[2][2];
    const char* cA = (const char*)g.A + (size_t)cur.pm * tstepA + (size_t)cur.ko * 2; const char* cB = (const char*)g.Bt + (size_t)cur.pn * tstepB + (size_t)cur.ko * 2;
    PG8_STAGE(PG8_SB(0, 0), cB, voffB); PG8_STAGE(PG8_SB(0, 1), cB + hstepB, voffB); PG8_STAGE(PG8_SA(0, 0), cA, voffA); PG8_STAGE(PG8_SA(0, 1), cA + hstepA, voffA);
    if (wr == 1) PG8_BAR;
    PG8_WAIT_V(2); PG8_BAR;
    PG8_STAGE(PG8_SB(1, 0), cB + kstep, voffB); PG8_STAGE(PG8_SA(1, 0), cA + kstep, voffA); PG8_STAGE(PG8_SB(1, 1), cB + hstepB + kstep, voffB);
    PG8_WAIT_V(6); PG8_BAR;
    for (;;) {
        const bool has_next = S.next(ui + 1, nxt);
        const char* nA = has_next ? (const char*)g.A + (size_t)nxt.pm * tstepA + (size_t)nxt.ko * 2 : cA; const char* nB = has_next ? (const char*)g.Bt + (size_t)nxt.pn * tstepB + (size_t)nxt.ko * 2 : cB;
        for (int t = 0; t < nt; t += 2) {
            if constexpr (Epi::HOOK) { if (t == Epi::HOOK_T) E.hook(acc, cur, wr, fr); }
            const bool last = (t == nt - 2);
            const char* a1 = cA + (size_t)(t + 1) * kstep;
            const char* a2 = last ? nA : cA + (size_t)(t + 2) * kstep; const char* b2 = last ? nB : cB + (size_t)(t + 2) * kstep;
            const char* a3 = a2 + kstep; const char* b3 = b2 + kstep;
            PG8_LDB(B0, 0, 0); PG8_LDB(B1, 0, 1); PG8_SCHED; PG8_LDA(At, 0, 0); PG8_STAGE(PG8_SA(1, 1), a1 + hstepA, voffA);
            PG8_WAIT_V(8); PG8_WAIT_L(0); PG8_BAR; PG8_MMA(0, 0, At, B0); PG8_MMA(0, 1, At, B1); PG8_BAR; PG8_SCHED;
            PG8_LDA(At, 0, 1); PG8_STAGE(PG8_SB(0, 0), b2, voffB); PG8_STAGE(PG8_SB(0, 1), b2 + hstepB, voffB); PG8_STAGE(PG8_SA(0, 0), a2, voffA);
            PG8_WAIT_V(8); PG8_WAIT_L(0); PG8_BAR; PG8_MMA(1, 0, At, B0); PG8_MMA(1, 1, At, B1); PG8_BAR; PG8_SCHED;
            PG8_LDB(B0, 1, 0); PG8_LDB(B1, 1, 1); PG8_SCHED; PG8_LDA(At, 1, 0); PG8_STAGE(PG8_SA(0, 1), a2 + hstepA, voffA);
            PG8_WAIT_V(8); PG8_WAIT_L(0); PG8_BAR; PG8_MMA(0, 0, At, B0); PG8_MMA(0, 1, At, B1); PG8_BAR; PG8_SCHED;
            PG8_LDA(At, 1, 1); PG8_STAGE(PG8_SB(1, 0), b3, voffB); PG8_STAGE(PG8_SB(1, 1), b3 + hstepB, voffB); PG8_STAGE(PG8_SA(1, 0), a3, voffA);
            PG8_WAIT_V(8); PG8_WAIT_L(0); PG8_BAR; PG8_MMA(1, 0, At, B0); PG8_MMA(1, 1, At, B1); PG8_BAR; PG8_SCHED;
        }
        if (wr == 0) PG8_BAR;
        E(acc, cur, wr, wc, fr, fq);
        if (!has_next) break;
#pragma unroll
        for (int a = 0; a < 2; ++a)
#pragma unroll
            for (int b = 0; b < 2; ++b)
#pragma unroll
                for (int m = 0; m < 4; ++m)
#pragma unroll
                    for (int n = 0; n < 2; ++n) acc[a][b][m][n] = (f32x4){0.f, 0.f, 0.f, 0.f};
        cur = nxt; cA = nA; cB = nB; ++ui;
        if (wr == 1) PG8_BAR;
    }
    PG8_WAIT_V(0);
    PG8_BAR;
    asm volatile("" ::: "memory");
    __syncthreads();
#undef PG8_SA
#undef PG8_SB
#undef PG8_STAGE
#undef PG8_LDA
#undef PG8_LDB
#undef PG8_MMA
#undef PG8_WAIT_V
#undef PG8_WAIT_L
#undef PG8_BAR
#undef PG8_SCHED
}

struct Epi1 {
    static constexpr bool PERM = true, HOOK = false; static constexpr int HOOK_T = -1;
    bf16_t* VT; bf16_t* Z; bf16_t* XR; float* DT;
    __device__ __forceinline__ void hook(f32x4 (&)[2][2][4][2], const Unit&, int, int) const {}
    __device__ __forceinline__ void operator()(const f32x4 (&acc)[2][2][4][2], const Unit& u, int wr, int wc, int fr, int fq) const {
        const int pn = u.pn, pm = u.pm;
        if (pn < 2) {
            if (pm >= 64) return;
            const int b = pm >> 3;
#pragma unroll
            for (int ai = 0; ai < 2; ++ai)
#pragma unroll
                for (int m = 0; m < 4; ++m) { const int t = (pm & 7) * 256 + ai * 128 + wr * 64 + m * 16 + fr;
#pragma unroll
                    for (int bj = 0; bj < 2; ++bj)
#pragma unroll
                        for (int n = 0; n < 2; ++n) { const int cc = 128 * bj + 32 * wc + 8 * fq + 4 * n; bf16_t* p = VT + (size_t)(b * 256 + cc) * 4096 + pn * 2048 + t;
                            const f32x4 v = acc[ai][bj][m][n]; const unsigned w0 = pk2(v[0], v[1]), w1 = pk2(v[2], v[3]);
                            p[0] = (bf16_t)(w0 & 0xffffu); p[4096] = (bf16_t)(w0 >> 16); p[2 * 4096] = (bf16_t)(w1 & 0xffffu); p[3 * 4096] = (bf16_t)(w1 >> 16); } }
        } else if (pn < 12) {
            bf16_t* base; int ld, c0;
            if (pn < 5) { if (pm >= 64) return; base = Z; ld = 768; c0 = 256 * (pn - 2); } else { base = XR; ld = 1792; c0 = 256 * (pn - 5); }
#pragma unroll
            for (int ai = 0; ai < 2; ++ai)
#pragma unroll
                for (int m = 0; m < 4; ++m) { const int row = pm * 256 + ai * 128 + wr * 64 + m * 16 + fr;
#pragma unroll
                    for (int bj = 0; bj < 2; ++bj) { const f32x4 v0 = acc[ai][bj][m][0], v1 = acc[ai][bj][m][1];
                        u32x4 w; w.x = pk2(v0[0], v0[1]); w.y = pk2(v0[2], v0[3]); w.z = pk2(v1[0], v1[1]); w.w = pk2(v1[2], v1[3]);
                        *(u32x4*)(base + (size_t)row * ld + c0 + 128 * bj + 32 * wc + 8 * fq) = w; } }
        } else {
            if (wc == 0 && fq < 3) {
#pragma unroll
                for (int ai = 0; ai < 2; ++ai)
#pragma unroll
                    for (int m = 0; m < 4; ++m) { const int row = pm * 256 + ai * 128 + wr * 64 + m * 16 + fr;
#pragma unroll
                        for (int n = 0; n < 2; ++n) *(f32x4*)(DT + (size_t)row * 24 + 8 * fq + 4 * n) = acc[ai][0][m][n]; }
            }
        }
    }
};
struct EpiFP {
    static constexpr bool PERM = false, HOOK = false; static constexpr int HOOK_T = -1;
    float* FP;
    __device__ __forceinline__ void hook(f32x4 (&)[2][2][4][2], const Unit&, int, int) const {}
    __device__ __forceinline__ void operator()(const f32x4 (&acc)[2][2][4][2], const Unit& u, int wr, int wc, int fr, int fq) const {
        float* base = FP + (size_t)(u.ko >> 10) * 2048 * 2048;
#pragma unroll
        for (int ai = 0; ai < 2; ++ai)
#pragma unroll
            for (int m = 0; m < 4; ++m) { float* rowp = base + (size_t)(u.pm * 256 + ai * 128 + wr * 64 + m * 16 + fr) * 2048 + u.pn * 256 + wc * 32 + 4 * fq;
#pragma unroll
                for (int bj = 0; bj < 2; ++bj)
#pragma unroll
                    for (int n = 0; n < 2; ++n) *(f32x4*)(rowp + bj * 128 + n * 16) = acc[ai][bj][m][n]; }
    }
};
template <bool HK> struct EpiNorm {
    static constexpr bool PERM = true, HOOK = HK; static constexpr int HOOK_T = 12;
    bf16_t* O; float* SSQ; const float* SSQG;
    __device__ __forceinline__ void hook(f32x4 (&acc)[2][2][4][2], const Unit& u, int wr, int fr) const {
#pragma unroll
        for (int ai = 0; ai < 2; ++ai)
#pragma unroll
            for (int m = 0; m < 4; ++m) { const int row = u.pm * 256 + ai * 128 + wr * 64 + m * 16 + fr;
                const f32x4 s = *(const f32x4*)(SSQG + (size_t)row * 4); const float rs = rsqrtf(((s[0] + s[1]) + (s[2] + s[3])) * (1.0f / 768.0f) + EPS);
#pragma unroll
                for (int bj = 0; bj < 2; ++bj)
#pragma unroll
                    for (int n = 0; n < 2; ++n) acc[ai][bj][m][n] *= rs; }
    }
    __device__ __forceinline__ void operator()(const f32x4 (&acc)[2][2][4][2], const Unit& u, int wr, int wc, int fr, int fq) const {
#pragma unroll
        for (int ai = 0; ai < 2; ++ai)
#pragma unroll
            for (int m = 0; m < 4; ++m) { const int row = u.pm * 256 + ai * 128 + wr * 64 + m * 16 + fr; float s = 0.f;
#pragma unroll
                for (int bj = 0; bj < 2; ++bj) { const f32x4 v0 = acc[ai][bj][m][0], v1 = acc[ai][bj][m][1];
                    s += (v0[0] * v0[0] + v0[1] * v0[1]) + (v0[2] * v0[2] + v0[3] * v0[3]) + (v1[0] * v1[0] + v1[1] * v1[1]) + (v1[2] * v1[2] + v1[3] * v1[3]);
                    u32x4 w; w.x = pk2(v0[0], v0[1]); w.y = pk2(v0[2], v0[3]); w.z = pk2(v1[0], v1[1]); w.w = pk2(v1[2], v1[3]);
                    *(u32x4*)(O + (size_t)row * 1024 + u.pn * 256 + 128 * bj + 32 * wc + 8 * fq) = w; }
                s += __shfl_xor(s, 16); s += __shfl_xor(s, 32);
                if (fq == 0) SSQ[(size_t)row * 16 + u.pn * 4 + wc] = s; }
    }
};
struct EpiSwiglu {
    static constexpr bool PERM = true, HOOK = false; static constexpr int HOOK_T = -1;
    bf16_t* Gb;
    __device__ __forceinline__ void hook(f32x4 (&)[2][2][4][2], const Unit&, int, int) const {}
    __device__ __forceinline__ void operator()(const f32x4 (&acc)[2][2][4][2], const Unit& u, int wr, int wc, int fr, int fq) const {
#pragma unroll
        for (int ai = 0; ai < 2; ++ai)
#pragma unroll
            for (int m = 0; m < 4; ++m) { const int row = u.pm * 256 + ai * 128 + wr * 64 + m * 16 + fr;
                float h[8];
#pragma unroll
                for (int n = 0; n < 2; ++n)
#pragma unroll
                    for (int j = 0; j < 4; ++j) h[n * 4 + j] = silu_f(acc[ai][0][m][n][j]) * acc[ai][1][m][n][j];
                u32x4 w; w.x = pk2(h[0], h[1]); w.y = pk2(h[2], h[3]); w.z = pk2(h[4], h[5]); w.w = pk2(h[6], h[7]);
                *(u32x4*)(Gb + (size_t)row * DFF + u.pn * 128 + 32 * wc + 8 * fq) = w; }
    }
};
}

__device__ __forceinline__ void p0_gemv(const Params& P, ldsp lds, int unit) {
    LAS float* s = (LAS float*)lds; LAS float* red = s + 9 * 1024;
    const int tid = threadIdx.x;
    const float* c = P.in[1]; const float* cctx = P.in[3]; const float* w_ada = P.in[4]; const float* b_ada = P.in[5];
    float* mod = (float*)(P.ws + WS_MOD);
    for (int i = tid; i < 9 * 1024; i += NTHR) { const int r = i >> 10, k = i & 1023; const float v = (r < 8) ? c[r * 1024 + k] : cctx[k]; s[i] = v / (1.0f + expf(-v)); }
    __syncthreads();
    const int cgi = tid & 31, kg = tid >> 5, col = unit * 32 + cgi;
    float acc[9];
#pragma unroll
    for (int r = 0; r < 9; ++r) acc[r] = 0.f;
#pragma unroll 4
    for (int kk = 0; kk < 64; ++kk) { const int k = kg * 64 + kk; const float w = w_ada[(size_t)k * 6144 + col];
#pragma unroll
        for (int r = 0; r < 9; ++r) acc[r] += s[r * 1024 + k] * w; }
#pragma unroll
    for (int r = 0; r < 9; ++r) red[(kg * 9 + r) * 32 + cgi] = acc[r];
    __syncthreads();
    if (tid < 288) { const int r = tid >> 5, c2 = tid & 31; float sum = 0.f;
#pragma unroll
        for (int q = 0; q < 16; ++q) sum += red[(q * 9 + r) * 32 + c2];
        mod[r * 6144 + unit * 32 + c2] = sum + b_ada[unit * 32 + c2]; }
    __syncthreads();
}
__device__ __forceinline__ void tr_item(const float* src, int spitch, int ks0, int c0, int nvalid, bf16_t* dst, int dpitch, int n0, int k0, const float* kscale, LAS float* scr, int lane) {
#pragma unroll 8
    for (int i = 0; i < 32; ++i) { const int kk = 2 * i + (lane >> 5), n = lane & 31; float v = 0.f;
        if (n < nvalid) v = src[(size_t)(ks0 + kk) * spitch + c0 + n];
        if (kscale) v *= kscale[kk];
        scr[kk * 33 + n] = v; }
    LDS_WAIT();
    const int c = lane & 7;
#pragma unroll
    for (int j = 0; j < 4; ++j) { const int n = (lane >> 3) + 8 * j; const LAS float* s = scr + (8 * c) * 33 + n;
        u32x4 o; o.x = pk2(s[0 * 33], s[1 * 33]); o.y = pk2(s[2 * 33], s[3 * 33]); o.z = pk2(s[4 * 33], s[5 * 33]); o.w = pk2(s[6 * 33], s[7 * 33]);
        *(u32x4*)(dst + (size_t)(n0 + n) * dpitch + k0 + 8 * c) = o; }
    LDS_WAIT();
}
__device__ __forceinline__ void p0_prep(const Params& P, ldsp lds) {
    const int tid = threadIdx.x, lane = tid & 63, wave = tid >> 6, G = gridDim.x;
    for (int u = blockIdx.x; u < 192; u += G) p0_gemv(P, lds, u);
    LAS float* tab = (LAS float*)lds;
    LAS float* tab64 = (LAS float*)(lds + 8192 + 8 * 8448);
    for (int i = tid; i < 2048; i += NTHR) tab[i] = cospif((float)i * (1.0f / 1024.0f));
    if (tid < 64) tab64[tid] = cospif((float)tid * (1.0f / 32.0f));
    __syncthreads();
    LAS float* scr = (LAS float*)(lds + 8192 + wave * 8448);
    const float* w_in = P.in[10]; const float* g_ssd = P.in[16]; const float* w_out = P.in[17]; const float* w_gate = P.in[18]; const float* w_up = P.in[19]; const float* w_down = P.in[20];
    bf16_t* W1T = (bf16_t*)(P.ws + WS_W1T); bf16_t* WOT = (bf16_t*)(P.ws + WS_WOT); bf16_t* WGUT = (bf16_t*)(P.ws + WS_WGUT); bf16_t* WDT = (bf16_t*)(P.ws + WS_WDT);
    const int gw = blockIdx.x * NWAVE + wave, NGW = G * NWAVE;
    constexpr int I_A = 88 * 16, I_B = 32 * 16, I_C = 176 * 16, I_D = 32 * 44, I_E = 256;
    for (int it = gw; it < I_A + I_B + I_C + I_D + I_E; it += NGW) {
        int r = it;
        if (r < I_E) {
            const int kb = r & 15, g = (r >> 4) & 3, cs = (r >> 6) & 1, half = r >> 7, k = kb * 64 + lane;
            float a[32];
#pragma unroll
            for (int kp = 0; kp < 32; ++kp) a[kp] = 0.f;
#pragma unroll 1
            for (int jc = 0; jc < 8; ++jc) { const f32x4 t0 = *(const f32x4*)(w_in + (size_t)k * INW + g * 64 + jc * 8), t1 = *(const f32x4*)(w_in + (size_t)k * INW + g * 64 + jc * 8 + 4);
                const float v[8] = {t0[0], t0[1], t0[2], t0[3], t1[0], t1[1], t1[2], t1[3]};
#pragma unroll
                for (int kp = 0; kp < 32; ++kp) { const int k2 = half * 32 + kp;
#pragma unroll
                    for (int jj = 0; jj < 8; ++jj) a[kp] += v[jj] * tab64[((jc * 8 + jj) * k2 - 16 * cs) & 63]; } }
#pragma unroll
            for (int kp = 0; kp < 32; ++kp) W1T[(size_t)(cs * 256 + g * 64 + half * 32 + kp) * 1024 + k] = (bf16_t)(pk2(a[kp] * 0.125f, 0.f) & 0xffffu);
            continue; }
        r -= I_E;
        if (r < I_A) { const int nb = 16 + r / 16, kb = r % 16, n0 = nb * 32; int c0 = 0, nv = 32;
            if (n0 < 1280) c0 = 256 + (n0 - 512); else if (n0 < 3072) c0 = 1024 + (n0 - 1280); else if (n0 == 3072) { c0 = 2816; nv = 24; } else nv = 0;
            tr_item(w_in, INW, kb * 64, c0, nv, W1T, 1024, n0, kb * 64, nullptr, scr, lane); continue; }
        r -= I_A;
        if (r < I_B) { const int nb = r / 16, kb = r % 16, k0 = kb * 64;
            if (k0 < 768) tr_item(w_out, 1024, 256 + k0, nb * 32, 32, WOT, 1024, nb * 32, k0, g_ssd + k0, scr, lane);
            else tr_item(w_out, 1024, k0 - 768, nb * 32, 32, WOT, 1024, nb * 32, k0, nullptr, scr, lane);
            continue; }
        r -= I_B;
        if (r < I_C) { const int nb = r / 16, kb = r % 16, n0 = nb * 32, pn = n0 >> 8, bj = (n0 >> 7) & 1, i0 = n0 & 127;
            tr_item(bj ? w_up : w_gate, DFF, kb * 64, 128 * pn + i0, 32, WGUT, 1024, n0, kb * 64, nullptr, scr, lane); continue; }
        r -= I_C;
        { const int nb = r / 44, kb = r % 44; tr_item(w_down, 1024, kb * 64, nb * 32, 32, WDT, DFF, nb * 32, kb * 64, nullptr, scr, lane); }
    }
    bf16_t* T = (bf16_t*)(P.ws + WS_T);
    for (int it = blockIdx.x * NTHR + tid; it < 2048 * 512; it += G * NTHR) {
        const int tp = it >> 9, kk0 = (it & 511) * 8, cs = kk0 >> 11, t0 = kk0 & 2047; float v[8];
#pragma unroll
        for (int e = 0; e < 8; ++e) { const int idx = ((t0 + e) * tp) & 2047; v[e] = (cs ? -tab[(idx - 512) & 2047] : tab[idx]) * 0.02209708691f; }
        u32x4 o; o.x = pk2(v[0], v[1]); o.y = pk2(v[2], v[3]); o.z = pk2(v[4], v[5]); o.w = pk2(v[6], v[7]);
        *(u32x4*)(T + (size_t)tp * 4096 + kk0) = o; }
}

__device__ __forceinline__ void p1_norm(const Params& P) {
    const int tid = threadIdx.x, lane = tid & 63, wave = tid >> 6, G = gridDim.x;
    const int gw = blockIdx.x * NWAVE + wave, NGW = G * NWAVE, rpw = (MALL + NGW - 1) / NGW;
    const float* x = P.in[0]; const float* ctx = P.in[2]; const float* gpre = P.in[6]; const float* mod = (const float*)(P.ws + WS_MOD);
    bf16_t* H = (bf16_t*)(P.ws + WS_H);
    int curb = -1; f32x4 a[4], sft[4];
    for (int i = 0; i < rpw; ++i) { const int row = gw * rpw + i; if (row >= MALL) break;
        const int mb = row < MLAT ? (row >> 11) : 8; const float* src = row < MLAT ? x + (size_t)row * DM : ctx + (size_t)(row - MLAT) * DM;
        if (mb != curb) { curb = mb;
#pragma unroll
            for (int j = 0; j < 4; ++j) { const int k = 4 * lane + 256 * j; const f32x4 gg = *(const f32x4*)(gpre + k), sc = *(const f32x4*)(mod + mb * 6144 + 1024 + k);
                a[j] = gg * (sc + 1.0f); sft[j] = *(const f32x4*)(mod + mb * 6144 + k); } }
        f32x4 v[4]; float ss = 0.f;
#pragma unroll
        for (int j = 0; j < 4; ++j) { v[j] = *(const f32x4*)(src + 4 * lane + 256 * j); ss += (v[j][0] * v[j][0] + v[j][1] * v[j][1]) + (v[j][2] * v[j][2] + v[j][3] * v[j][3]); }
        const float rstd = rsqrtf(wave_sum(ss) * (1.0f / DM) + EPS);
#pragma unroll
        for (int j = 0; j < 4; ++j) { const f32x4 h = v[j] * rstd * a[j] + sft[j]; u32x2 w; w.x = pk2(h[0], h[1]); w.y = pk2(h[2], h[3]);
            *(u32x2*)(H + (size_t)row * DM + 4 * lane + 256 * j) = w; }
    }
}

__device__ __forceinline__ void p3_conv(const Params& P) {
    const int G = gridDim.x;
    const bf16_t* XR = (const bf16_t*)P.out; bf16_t* XBC = (bf16_t*)(P.ws + WS_XBC);
    const float* conv_w = P.in[11]; const float* conv_b = P.in[12];
    for (int it = blockIdx.x * NTHR + threadIdx.x; it < 576 * 224; it += G * NTHR) {
        const int cg8 = it % 224, seg = it / 224, c0 = cg8 * 8, r0 = seg * 32;
        int rs, re; if (r0 < MLAT) { rs = r0 & ~63; re = rs + 64; } else { rs = MLAT + ((r0 - MLAT) & ~255); re = rs + 256; }
        float w[8][7], bias[8];
#pragma unroll
        for (int c = 0; c < 8; ++c) { bias[c] = conv_b[c0 + c];
#pragma unroll
            for (int k = 0; k < 7; ++k) w[c][k] = conv_w[(c0 + c) * 7 + k]; }
        float win[7][8];
#pragma unroll
        for (int k = 0; k < 7; ++k)
#pragma unroll
            for (int c = 0; c < 8; ++c) win[k][c] = 0.f;
#pragma unroll
        for (int i = 0; i < 38; ++i) { const int src = r0 - 3 + i;
#pragma unroll
            for (int k = 0; k < 6; ++k)
#pragma unroll
                for (int c = 0; c < 8; ++c) win[k][c] = win[k + 1][c];
            u32x4 raw = (u32x4){0u, 0u, 0u, 0u};
            if (src >= rs && src < re) raw = *(const u32x4*)(XR + (size_t)src * 1792 + c0);
            win[6][0] = bflo(raw.x); win[6][1] = bfhi(raw.x); win[6][2] = bflo(raw.y); win[6][3] = bfhi(raw.y); win[6][4] = bflo(raw.z); win[6][5] = bfhi(raw.z); win[6][6] = bflo(raw.w); win[6][7] = bfhi(raw.w);
            if (i >= 6) { float o[8];
#pragma unroll
                for (int c = 0; c < 8; ++c) { float a = bias[c];
#pragma unroll
                    for (int k = 0; k < 7; ++k) a += w[c][k] * win[k][c];
                    o[c] = silu_f(a); }
                u32x4 ov; ov.x = pk2(o[0], o[1]); ov.y = pk2(o[2], o[3]); ov.z = pk2(o[4], o[5]); ov.w = pk2(o[6], o[7]);
                *(u32x4*)(XBC + (size_t)(r0 + i - 6) * 1792 + c0) = ov; } }
    }
}

__device__ __forceinline__ float softplus_f(float x) { return x > 20.f ? x : log1pf(expf(x)); }
__device__ __forceinline__ void chunk_scan(const float* DT, size_t rowbase, int col, float bias, float negA, int lane,
                                           float& dt0, float& dt1, float& pi0, float& pi1, float& pe0, float& pe1, float& total) {
    const float r0 = DT[(rowbase + 2 * lane) * 24 + col], r1 = DT[(rowbase + 2 * lane + 1) * 24 + col];
    dt0 = softplus_f(r0 + bias); dt1 = softplus_f(r1 + bias);
    const float a0 = dt0 * negA, a1 = dt1 * negA; float p = a0 + a1;
#pragma unroll
    for (int o = 1; o < 64; o <<= 1) { const float v = __shfl_up(p, o); if (lane >= o) p += v; }
    total = __shfl(p, 63);
    pi1 = p; pi0 = p - a1; pe1 = pi0; pe0 = pi0 - a0;
}
__device__ __forceinline__ void load_transposed(const bf16_t* src, int nch8, LAS bf16_t* dst, int tid) {
    const int nitem = nch8 * 64;
    for (int idx = tid; idx < nitem; idx += NTHR) { const int q = idx >> 5, s2 = (idx & 31) + 32 * (q & 1), ch8 = q >> 1;
        const u32x4 lo = *(const u32x4*)(src + (size_t)(2 * s2) * 1792 + ch8 * 8), hi = *(const u32x4*)(src + (size_t)(2 * s2 + 1) * 1792 + ch8 * 8);
        LAS unsigned* d = (LAS unsigned*)(dst + (ch8 * 8) * 136 + 2 * s2);
        d[0 * 68] = (lo.x & 0xffffu) | (hi.x << 16); d[1 * 68] = (lo.x >> 16) | (hi.x & 0xffff0000u);
        d[2 * 68] = (lo.y & 0xffffu) | (hi.y << 16); d[3 * 68] = (lo.y >> 16) | (hi.y & 0xffff0000u);
        d[4 * 68] = (lo.z & 0xffffu) | (hi.z << 16); d[5 * 68] = (lo.z >> 16) | (hi.z & 0xffff0000u);
        d[6 * 68] = (lo.w & 0xffffu) | (hi.w << 16); d[7 * 68] = (lo.w >> 16) | (hi.w & 0xffff0000u); }
}
__device__ __forceinline__ bf16x8 scale8(bf16x8 x, f32x4 w0, f32x4 w1) {
    const u32x4 u = __builtin_bit_cast(u32x4, x); u32x4 o;
    o.x = pk2(bflo(u.x) * w0[0], bfhi(u.x) * w0[1]); o.y = pk2(bflo(u.y) * w0[2], bfhi(u.y) * w0[3]);
    o.z = pk2(bflo(u.z) * w1[0], bfhi(u.z) * w1[1]); o.w = pk2(bflo(u.w) * w1[2], bfhi(u.w) * w1[3]);
    return __builtin_bit_cast(bf16x8, o);
}

__device__ __forceinline__ void ssd_states_unit(const Params& P, ldsp lds, int u) {
    const int tid = threadIdx.x, lane = tid & 63, wave = __builtin_amdgcn_readfirstlane(tid >> 6), fr = lane & 15, fq = lane >> 4;
    int b, c, g; size_t rowbase; bf16_t* STb; float* AE;
    if (u < 512) { b = u >> 6; c = (u >> 2) & 15; g = u & 3; rowbase = (size_t)b * SEQ + c * 128;
        STb = (bf16_t*)(P.ws + WS_ST) + (size_t)(b * 16 + c) * 24 * 8192; AE = (float*)(P.ws + WS_AEND) + (b * 16 + c) * 24; }
    else { const int v = u - 512; b = v >> 3; c = (v >> 2) & 1; g = v & 3; rowbase = (size_t)MLAT + b * CTXL + c * 128;
        STb = (bf16_t*)(P.ws + WS_STC) + (size_t)(b * 2 + c) * 24 * 8192; AE = (float*)(P.ws + WS_AENDC) + (b * 2 + c) * 24; }
    const bf16_t* XBC = (const bf16_t*)(P.ws + WS_XBC); const float* DT = (const float*)(P.ws + WS_DT);
    LAS bf16_t* BT = (LAS bf16_t*)lds; LAS bf16_t* XT = (LAS bf16_t*)(lds + 34816); LAS float* wl = (LAS float*)(lds + 87040);
    if (wave < 6) { const int r = wave % 3, dir = wave / 3, hd = dir * 12 + g * 3 + r;
        float dt0, dt1, pi0, pi1, pe0, pe1, tot;
        chunk_scan(DT, rowbase, hd, P.in[13][hd], -expf(P.in[14][hd]), lane, dt0, dt1, pi0, pi1, pe0, pe1, tot);
        float w0, w1; if (dir == 0) { w0 = dt0 * __expf(tot - pi0); w1 = dt1 * __expf(tot - pi1); } else { w0 = dt0 * __expf(pe0); w1 = dt1 * __expf(pe1); }
        wl[wave * 128 + 2 * lane] = w0; wl[wave * 128 + 2 * lane + 1] = w1;
        if (lane == 0) AE[hd] = tot; }
    load_transposed(XBC + rowbase * 1792 + 768 + g * 128, 16, BT, tid);
    load_transposed(XBC + rowbase * 1792 + g * 192, 24, XT, tid);
    __syncthreads();
    bf16x8 bfr[4];
#pragma unroll
    for (int kk = 0; kk < 4; ++kk) bfr[kk] = *(const LAS bf16x8*)(BT + (16 * wave + fr) * 136 + kk * 32 + fq * 8);
#pragma unroll 1
    for (int combo = 0; combo < 6; ++combo) { const int r = combo % 3, dir = combo / 3;
        f32x4 acc[4];
#pragma unroll
        for (int mb = 0; mb < 4; ++mb) acc[mb] = (f32x4){0.f, 0.f, 0.f, 0.f};
#pragma unroll
        for (int kk = 0; kk < 4; ++kk) { const f32x4 w0 = *(const LAS f32x4*)(wl + combo * 128 + kk * 32 + fq * 8), w1 = *(const LAS f32x4*)(wl + combo * 128 + kk * 32 + fq * 8 + 4);
#pragma unroll
            for (int mb = 0; mb < 4; ++mb) { const bf16x8 xr = *(const LAS bf16x8*)(XT + (r * 64 + mb * 16 + fr) * 136 + kk * 32 + fq * 8);
                acc[mb] = __builtin_amdgcn_mfma_f32_16x16x32_bf16(bfr[kk], scale8(xr, w0, w1), acc[mb], 0, 0, 0); } }
        bf16_t* dst = STb + (size_t)(dir * 12 + g * 3 + r) * 8192;
#pragma unroll
        for (int mb = 0; mb < 4; ++mb) { u32x2 w; w.x = pk2(acc[mb][0], acc[mb][1]); w.y = pk2(acc[mb][2], acc[mb][3]);
            *(u32x2*)(dst + (mb * 16 + fr) * 128 + 16 * wave + 4 * fq) = w; } }
    __syncthreads();
}

__device__ __forceinline__ void p5_scan(const Params& P) {
    const int G = gridDim.x;
    bf16_t* ST = (bf16_t*)(P.ws + WS_ST); const bf16_t* STC = (const bf16_t*)(P.ws + WS_STC);
    const float* AE = (const float*)(P.ws + WS_AEND); const float* AEC = (const float*)(P.ws + WS_AENDC);
    for (int it = blockIdx.x * NTHR + threadIdx.x; it < NB * 24 * 1024; it += G * NTHR) {
        const int e8 = it & 1023, dh = (it >> 10) % 24, b = it / (24 * 1024), dir = dh / 12;
        float h[8];
#pragma unroll
        for (int e = 0; e < 8; ++e) h[e] = 0.f;
#pragma unroll
        for (int ci = 0; ci < 2; ++ci) { const int c = dir ? 1 - ci : ci; const float a = __expf(AEC[(b * 2 + c) * 24 + dh]);
            const u32x4 s = *(const u32x4*)(STC + ((size_t)(b * 2 + c) * 24 + dh) * 8192 + e8 * 8);
            h[0] = a * h[0] + bflo(s.x); h[1] = a * h[1] + bfhi(s.x); h[2] = a * h[2] + bflo(s.y); h[3] = a * h[3] + bfhi(s.y);
            h[4] = a * h[4] + bflo(s.z); h[5] = a * h[5] + bfhi(s.z); h[6] = a * h[6] + bflo(s.w); h[7] = a * h[7] + bfhi(s.w); }
#pragma unroll
        for (int ci = 0; ci < 16; ++ci) { const int c = dir ? 15 - ci : ci; const float a = __expf(AE[(b * 16 + c) * 24 + dh]);
            bf16_t* p = ST + ((size_t)(b * 16 + c) * 24 + dh) * 8192 + e8 * 8;
            const u32x4 s = *(const u32x4*)p;
            u32x4 o; o.x = pk2(h[0], h[1]); o.y = pk2(h[2], h[3]); o.z = pk2(h[4], h[5]); o.w = pk2(h[6], h[7]);
            *(u32x4*)p = o;
            h[0] = a * h[0] + bflo(s.x); h[1] = a * h[1] + bfhi(s.x); h[2] = a * h[2] + bflo(s.y); h[3] = a * h[3] + bfhi(s.y);
            h[4] = a * h[4] + bflo(s.z); h[5] = a * h[5] + bfhi(s.z); h[6] = a * h[6] + bflo(s.w); h[7] = a * h[7] + bfhi(s.w); }
    }
    const float* FP = (const float*)P.out; bf16_t* ACAT = (bf16_t*)(P.ws + WS_ACAT);
    for (int it = blockIdx.x * NTHR + threadIdx.x; it < 2048 * 256; it += G * NTHR) {
        const int c8 = it & 255, tp = it >> 8, col = c8 * 8, b = col >> 8, cc = col & 255;
        f32x4 s0 = (f32x4){0.f, 0.f, 0.f, 0.f}, s1 = s0;
#pragma unroll
        for (int ks = 0; ks < 4; ++ks) { const float* p = FP + ((size_t)ks * 2048 + tp) * 2048 + col; s0 += *(const f32x4*)p; s1 += *(const f32x4*)(p + 4); }
        u32x4 o; o.x = pk2(s0[0], s0[1]); o.y = pk2(s0[2], s0[3]); o.z = pk2(s1[0], s1[1]); o.w = pk2(s1[2], s1[3]);
        *(u32x4*)(ACAT + ((size_t)b * SEQ + tp) * 1024 + 768 + cc) = o; }
}

__device__ __forceinline__ void ssd_out_unit(const Params& P, ldsp lds, int u) {
    const int tid = threadIdx.x, lane = tid & 63, wave = __builtin_amdgcn_readfirstlane(tid >> 6), fr = lane & 15, fq = lane >> 4;
    const int b = u >> 6, c = (u >> 2) & 15, g = u & 3; const size_t rowbase = (size_t)b * SEQ + c * 128;
    const bf16_t* XBC = (const bf16_t*)(P.ws + WS_XBC); const float* DT = (const float*)(P.ws + WS_DT); const bf16_t* Zb = (const bf16_t*)(P.ws + WS_Z);
    const bf16_t* HIN = (const bf16_t*)(P.ws + WS_ST) + (size_t)(b * 16 + c) * 24 * 8192;
    bf16_t* ACAT = (bf16_t*)(P.ws + WS_ACAT); float* SSQG = (float*)(P.ws + WS_SSQG);
    LAS bf16_t* Cs = (LAS bf16_t*)lds; LAS bf16_t* Bs = (LAS bf16_t*)(lds + 34816); LAS bf16_t* XT = (LAS bf16_t*)(lds + 69632);
    LAS float* af = (LAS float*)(lds + 121856); LAS float* peb = af + 384; LAS float* dtf = peb + 384; LAS float* dtb = dtf + 384; LAS float* ef = dtb + 384; LAS float* eb = ef + 384;
    if (wave < 6) { const int r = wave % 3, dir = wave / 3, hd = dir * 12 + g * 3 + r;
        float dt0, dt1, pi0, pi1, pe0, pe1, tot;
        chunk_scan(DT, rowbase, hd, P.in[13][hd], -expf(P.in[14][hd]), lane, dt0, dt1, pi0, pi1, pe0, pe1, tot);
        const int i0 = r * 128 + 2 * lane;
        if (dir == 0) { af[i0] = pi0; af[i0 + 1] = pi1; dtf[i0] = dt0; dtf[i0 + 1] = dt1; ef[i0] = __expf(pi0); ef[i0 + 1] = __expf(pi1); }
        else { peb[i0] = pe0; peb[i0 + 1] = pe1; dtb[i0] = dt0; dtb[i0 + 1] = dt1; eb[i0] = __expf(tot - pe0); eb[i0 + 1] = __expf(tot - pe1); } }
    for (int idx = tid; idx < 2048; idx += NTHR) { const int row = idx >> 4, ch8 = idx & 15;
        *(LAS u32x4*)(Cs + row * 136 + ch8 * 8) = *(const u32x4*)(XBC + (rowbase + row) * 1792 + 1280 + g * 128 + ch8 * 8);
        *(LAS u32x4*)(Bs + row * 136 + ch8 * 8) = *(const u32x4*)(XBC + (rowbase + row) * 1792 + 768 + g * 128 + ch8 * 8); }
    load_transposed(XBC + rowbase * 1792 + g * 192, 24, XT, tid);
    __syncthreads();
    const int q = 16 * wave + fr;
    bf16x8 cfr[4];
#pragma unroll
    for (int kk = 0; kk < 4; ++kk) cfr[kk] = *(const LAS bf16x8*)(Cs + q * 136 + kk * 32 + fq * 8);
    f32x4 S[8];
#pragma unroll
    for (int sb = 0; sb < 8; ++sb) { S[sb] = (f32x4){0.f, 0.f, 0.f, 0.f};
#pragma unroll
        for (int kk = 0; kk < 4; ++kk) S[sb] = __builtin_amdgcn_mfma_f32_16x16x32_bf16(*(const LAS bf16x8*)(Bs + (sb * 16 + fr) * 136 + kk * 32 + fq * 8), cfr[kk], S[sb], 0, 0, 0); }
    float ssq = 0.f;
#pragma unroll 1
    for (int r = 0; r < 3; ++r) {
        const float afq = af[r * 128 + q], pebq = peb[r * 128 + q];
        f32x4 y[4];
#pragma unroll
        for (int pb = 0; pb < 4; ++pb) y[pb] = (f32x4){0.f, 0.f, 0.f, 0.f};
#pragma unroll
        for (int kk = 0; kk < 4; ++kk) { float mv[8];
#pragma unroll
            for (int hh = 0; hh < 2; ++hh) { const int sb = 2 * kk + hh, s0 = 16 * sb + 4 * fq;
                const f32x4 a4 = *(const LAS f32x4*)(af + r * 128 + s0), p4 = *(const LAS f32x4*)(peb + r * 128 + s0), df4 = *(const LAS f32x4*)(dtf + r * 128 + s0), db4 = *(const LAS f32x4*)(dtb + r * 128 + s0);
#pragma unroll
                for (int j = 0; j < 4; ++j) { const int s = s0 + j;
                    const float cf = (s <= q) ? __expf(afq - a4[j]) * df4[j] : 0.f, cb = (s >= q) ? __expf(p4[j] - pebq) * db4[j] : 0.f;
                    mv[hh * 4 + j] = S[sb][j] * (cf + cb); } }
            u32x4 mw; mw.x = pk2(mv[0], mv[1]); mw.y = pk2(mv[2], mv[3]); mw.z = pk2(mv[4], mv[5]); mw.w = pk2(mv[6], mv[7]);
            const bf16x8 mfr = __builtin_bit_cast(bf16x8, mw);
#pragma unroll
            for (int pb = 0; pb < 4; ++pb) { const LAS bf16_t* xp = XT + (r * 64 + pb * 16 + fr) * 136 + 32 * kk + 4 * fq;
                const u32x2 x0 = *(const LAS u32x2*)xp, x1 = *(const LAS u32x2*)(xp + 16);
                u32x4 xw; xw.x = x0.x; xw.y = x0.y; xw.z = x1.x; xw.w = x1.y;
                y[pb] = __builtin_amdgcn_mfma_f32_16x16x32_bf16(__builtin_bit_cast(bf16x8, xw), mfr, y[pb], 0, 0, 0); } }
#pragma unroll
        for (int dir = 0; dir < 2; ++dir) { const float e = dir ? eb[r * 128 + q] : ef[r * 128 + q];
            const bf16_t* hb = HIN + (size_t)(dir * 12 + g * 3 + r) * 8192;
#pragma unroll
            for (int pb = 0; pb < 4; ++pb) { f32x4 t = (f32x4){0.f, 0.f, 0.f, 0.f};
#pragma unroll
                for (int kk = 0; kk < 4; ++kk) { const bf16x8 hf = *(const bf16x8*)(hb + (pb * 16 + fr) * 128 + kk * 32 + fq * 8);
                    t = __builtin_amdgcn_mfma_f32_16x16x32_bf16(hf, cfr[kk], t, 0, 0, 0); }
                y[pb] += t * e; } }
        const float dsk = P.in[15][g * 3 + r];
#pragma unroll
        for (int pb = 0; pb < 4; ++pb) { const int ch = g * 192 + r * 64 + pb * 16 + 4 * fq;
            const u32x2 xv = *(const u32x2*)(XBC + (rowbase + q) * 1792 + ch), zv = *(const u32x2*)(Zb + (rowbase + q) * 768 + ch);
            const float o0 = (y[pb][0] + bflo(xv.x) * dsk) * silu_f(bflo(zv.x)), o1 = (y[pb][1] + bfhi(xv.x) * dsk) * silu_f(bfhi(zv.x)),
                        o2 = (y[pb][2] + bflo(xv.y) * dsk) * silu_f(bflo(zv.y)), o3 = (y[pb][3] + bfhi(xv.y) * dsk) * silu_f(bfhi(zv.y));
            ssq += (o0 * o0 + o1 * o1) + (o2 * o2 + o3 * o3);
            u32x2 w; w.x = pk2(o0, o1); w.y = pk2(o2, o3);
            *(u32x2*)(ACAT + (rowbase + q) * 1024 + ch) = w; }
    }
    ssq += __shfl_xor(ssq, 16); ssq += __shfl_xor(ssq, 32);
    if (fq == 0) SSQG[(rowbase + q) * 4 + g] = ssq;
    __syncthreads();
}

__device__ __forceinline__ f32x4 ld4bf(const bf16_t* p) { const u32x2 w = *(const u32x2*)p; return (f32x4){bflo(w.x), bfhi(w.x), bflo(w.y), bfhi(w.y)}; }
__device__ __forceinline__ float ssq16(const float* p) { const f32x4 a = *(const f32x4*)p, b = *(const f32x4*)(p + 4), c = *(const f32x4*)(p + 8), d = *(const f32x4*)(p + 12);
    return ((a[0] + a[1]) + (a[2] + a[3])) + ((b[0] + b[1]) + (b[2] + b[3])) + ((c[0] + c[1]) + (c[2] + c[3])) + ((d[0] + d[1]) + (d[2] + d[3])); }
__device__ __forceinline__ void p8_mid(const Params& P) {
    const int tid = threadIdx.x, lane = tid & 63, wave = tid >> 6, G = gridDim.x;
    const int gw = blockIdx.x * NWAVE + wave, NGW = G * NWAVE, rpw = (MLAT + NGW - 1) / NGW;
    const float* x = P.in[0]; const float* gpm = P.in[7]; const float* gpf = P.in[8]; const float* mod = (const float*)(P.ws + WS_MOD);
    const bf16_t* O1 = (const bf16_t*)(P.ws + WS_O1); const float* SSQ1 = (const float*)(P.ws + WS_SSQ1); bf16_t* H2 = (bf16_t*)(P.ws + WS_H);
    int curb = -1; f32x4 ga[4], a2[4], s2[4];
    for (int i = 0; i < rpw; ++i) { const int row = gw * rpw + i; if (row >= MLAT) break;
        const int mb = row >> 11;
        if (mb != curb) { curb = mb;
#pragma unroll
            for (int j = 0; j < 4; ++j) { const int k = 4 * lane + 256 * j; const float* m = mod + mb * 6144 + k;
                ga[j] = *(const f32x4*)(m + 2048) * *(const f32x4*)(gpm + k); a2[j] = *(const f32x4*)(gpf + k) * (*(const f32x4*)(m + 4096) + 1.0f); s2[j] = *(const f32x4*)(m + 3072); } }
        const float rstd1 = rsqrtf(ssq16(SSQ1 + (size_t)row * 16) * (1.0f / DM) + EPS);
        f32x4 v[4]; float ss = 0.f;
#pragma unroll
        for (int j = 0; j < 4; ++j) { const int k = 4 * lane + 256 * j; v[j] = *(const f32x4*)(x + (size_t)row * DM + k) + ga[j] * ld4bf(O1 + (size_t)row * DM + k) * rstd1;
            *(f32x4*)(P.out + (size_t)row * DM + k) = v[j]; ss += (v[j][0] * v[j][0] + v[j][1] * v[j][1]) + (v[j][2] * v[j][2] + v[j][3] * v[j][3]); }
        const float rstd2 = rsqrtf(wave_sum(ss) * (1.0f / DM) + EPS);
#pragma unroll
        for (int j = 0; j < 4; ++j) { const f32x4 h = v[j] * rstd2 * a2[j] + s2[j]; u32x2 w; w.x = pk2(h[0], h[1]); w.y = pk2(h[2], h[3]);
            *(u32x2*)(H2 + (size_t)row * DM + 4 * lane + 256 * j) = w; }
    }
}
__device__ __forceinline__ void p11_final(const Params& P) {
    const int tid = threadIdx.x, lane = tid & 63, wave = tid >> 6, G = gridDim.x;
    const int gw = blockIdx.x * NWAVE + wave, NGW = G * NWAVE, rpw = (MLAT + NGW - 1) / NGW;
    const float* gpo = P.in[9]; const float* mod = (const float*)(P.ws + WS_MOD);
    const bf16_t* F2 = (const bf16_t*)(P.ws + WS_O1); const float* SSQ2 = (const float*)(P.ws + WS_SSQ2);
    int curb = -1; f32x4 ga[4];
    for (int i = 0; i < rpw; ++i) { const int row = gw * rpw + i; if (row >= MLAT) break;
        const int mb = row >> 11;
        if (mb != curb) { curb = mb;
#pragma unroll
            for (int j = 0; j < 4; ++j) { const int k = 4 * lane + 256 * j; ga[j] = *(const f32x4*)(mod + mb * 6144 + 5120 + k) * *(const f32x4*)(gpo + k); } }
        const float rstd = rsqrtf(ssq16(SSQ2 + (size_t)row * 16) * (1.0f / DM) + EPS);
#pragma unroll
        for (int j = 0; j < 4; ++j) { const int k = 4 * lane + 256 * j; float* o = P.out + (size_t)row * DM + k;
            *(f32x4*)o = *(const f32x4*)o + ga[j] * ld4bf(F2 + (size_t)row * DM + k) * rstd; }
    }
}

__global__ void __launch_bounds__(NTHR, 2) mega(Params P, int lo, int hi) {
    extern __shared__ __attribute__((aligned(16))) unsigned char lds_raw[];
    ldsp lds = (ldsp)lds_raw;
    cg::grid_group grid = cg::this_grid();
    const int G = gridDim.x;
    unsigned char* ws = P.ws;
#ifndef PH_MASK
#define PH_MASK 0xfff
#endif
#define IN(k) (((PH_MASK >> (k)) & 1) && lo <= (k) && (k) < hi)
#define SEAM(k) do { if (IN(k) && IN((k) + 1)) grid.sync(); } while (0)
    if (IN(0)) p0_prep(P, lds);
    SEAM(0);
    if (IN(1)) p1_norm(P);
    SEAM(1);
    if (IN(2)) { pg8::Gemm g{(const bf16_t*)(ws + WS_H), (const bf16_t*)(ws + WS_W1T), 1024, 1024, 1024}; pg8::StaticOrder S; S.init(MALL, N1, G, (int)blockIdx.x);
        pg8::Epi1 E{(bf16_t*)(ws + WS_VT), (bf16_t*)(ws + WS_Z), (bf16_t*)P.out, (float*)(ws + WS_DT)};
        pg8::gemm_phase(lds, g, S, E); }
    SEAM(2);
    if (IN(3)) p3_conv(P);
    SEAM(3);
    if (IN(4)) { { pg8::Gemm g{(const bf16_t*)(ws + WS_T), (const bf16_t*)(ws + WS_VT), 4096, 4096, 1024}; pg8::SplitKOrder S{G, (int)blockIdx.x};
            pg8::EpiFP E{P.out}; pg8::gemm_phase(lds, g, S, E); }
        for (int u = blockIdx.x; u < 576; u += G) ssd_states_unit(P, lds, u); }
    SEAM(4);
    if (IN(5)) p5_scan(P);
    SEAM(5);
    if (IN(6)) { for (int u = blockIdx.x; u < 512; u += G) ssd_out_unit(P, lds, u); }
    SEAM(6);
    if (IN(7)) { pg8::Gemm g{(const bf16_t*)(ws + WS_ACAT), (const bf16_t*)(ws + WS_WOT), 1024, 1024, 1024}; pg8::StaticOrder S; S.init(MLAT, 1024, G, (int)blockIdx.x);
        pg8::EpiNorm<true> E{(bf16_t*)(ws + WS_O1), (float*)(ws + WS_SSQ1), (const float*)(ws + WS_SSQG)};
        pg8::gemm_phase(lds, g, S, E); }
    SEAM(7);
    if (IN(8)) p8_mid(P);
    SEAM(8);
    if (IN(9)) { pg8::Gemm g{(const bf16_t*)(ws + WS_H), (const bf16_t*)(ws + WS_WGUT), 1024, 1024, 1024}; pg8::StaticOrder S; S.init(MLAT, 2 * DFF, G, (int)blockIdx.x);
        pg8::EpiSwiglu E{(bf16_t*)(ws + WS_G)};
        pg8::gemm_phase(lds, g, S, E); }
    SEAM(9);
    if (IN(10)) { pg8::Gemm g{(const bf16_t*)(ws + WS_G), (const bf16_t*)(ws + WS_WDT), DFF, DFF, DFF}; pg8::StaticOrder S; S.init(MLAT, 1024, G, (int)blockIdx.x);
        pg8::EpiNorm<false> E{(bf16_t*)(ws + WS_O1), (float*)(ws + WS_SSQ2), nullptr};
        pg8::gemm_phase(lds, g, S, E); }
    SEAM(10);
    if (IN(11)) p11_final(P);
#undef IN
#undef SEAM
}


#ifdef PROBE_K
__global__ void dump_bf16(const bf16_t* src, int pitch, int ncols, float* out) {
    for (size_t i = (size_t)blockIdx.x * blockDim.x + threadIdx.x; i < (size_t)MLAT * DM; i += (size_t)gridDim.x * blockDim.x) {
        const int row = (int)(i >> 10), c = (int)(i & 1023);
        out[i] = c < ncols ? __uint_as_float((unsigned)src[(size_t)row * pitch + c] << 16) : 0.f; }
}
#endif
extern "C" void kernel_launch(void* const* d_in, const int* in_sizes, int n_in, void* d_out, int out_size, void* d_ws, size_t ws_size, hipStream_t stream) {
    static int grid = 0;
    if (grid == 0) {
        if (n_in != 21 || out_size != MLAT * DM || ws_size < WS_END) { fprintf(stderr, "kernel_launch: unexpected shapes (n_in %d out %d ws %zu)\n", n_in, out_size, ws_size); grid = -1; return; }
        int dev = 0, cus = 0, per_cu = 0;
        hipGetDevice(&dev); hipDeviceGetAttribute(&cus, hipDeviceAttributeMultiprocessorCount, dev);
        if (hipFuncSetAttribute((const void*)mega, hipFuncAttributeMaxDynamicSharedMemorySize, LDS_BYTES) != hipSuccess) { fprintf(stderr, "kernel_launch: hipFuncSetAttribute failed\n"); grid = -1; return; }
        if (hipOccupancyMaxActiveBlocksPerMultiprocessor(&per_cu, (const void*)mega, NTHR, LDS_BYTES) != hipSuccess || per_cu < 1) { fprintf(stderr, "kernel_launch: occupancy query gave %d\n", per_cu); per_cu = 1; }
        (void)hipGetLastError();
        grid = cus * 1;
    }
    if (grid < 0) return;
    Params p{};
    for (int i = 0; i < 21; ++i) p.in[i] = (const float*)d_in[i];
    p.out = (float*)d_out; p.ws = (unsigned char*)d_ws;
#if MK_LAUNCHES == 1
    int lo = 0, hi = 12;
    void* args[] = {&p, &lo, &hi};
    hipError_t e = hipLaunchCooperativeKernel((const void*)mega, dim3(grid), dim3(NTHR), args, LDS_BYTES, stream);
    if (e != hipSuccess) fprintf(stderr, "cooperative launch failed: %s (grid %d)\n", hipGetErrorString(e), grid);
#else
#ifdef PROBE_K
    for (int ph = 0; ph <= PROBE_K; ++ph) hipLaunchKernelGGL(mega, dim3(grid), dim3(NTHR), LDS_BYTES, stream, p, ph, ph + 1);
    hipLaunchKernelGGL(dump_bf16, dim3(2048), dim3(256), 0, stream, (const bf16_t*)((unsigned char*)d_ws + PROBE_OFF), PROBE_PITCH, PROBE_NCOLS, (float*)d_out);
#else
    for (int ph = 0; ph < 12; ++ph) hipLaunchKernelGGL(mega, dim3(grid), dim3(NTHR), LDS_BYTES, stream, p, ph, ph + 1);
#endif
#endif
}
```

```cpp
#include <hip/hip_runtime.h>
#include <hip/hip_cooperative_groups.h>
#include <cstdio>
#include <cstdint>
namespace cg = cooperative_groups;

#ifndef MK_LAUNCHES
#define MK_LAUNCHES 1
#endif

#define LAS __attribute__((address_space(3)))
typedef unsigned short bf16_t;
typedef short bf16x8 __attribute__((ext_vector_type(8)));
typedef float f32x4 __attribute__((ext_vector_type(4)));
typedef unsigned u32x4 __attribute__((ext_vector_type(4)));
typedef unsigned u32x2 __attribute__((ext_vector_type(2)));
typedef LAS unsigned char* ldsp;

constexpr int NB = 8, SEQ = 2048, DM = 1024, CTXL = 256;
constexpr int MLAT = NB * SEQ;
constexpr int MCTX = NB * CTXL;
constexpr int MALL = MLAT + MCTX;
constexpr int INW = 2840, DFF = 2816;
constexpr int N1 = 3328;
constexpr float EPS = 1e-6f;
constexpr int NTHR = 512, NWAVE = 8;
constexpr int LDS_BYTES = 143360;

constexpr size_t MiB = 1u << 20;
constexpr size_t WS_BAR = 512 * 1024, WS_MOD = 0, WS_DT = 1 * MiB, WS_SSQG = 3 * MiB, WS_SSQ1 = 3 * MiB + 256 * 1024, WS_SSQ2 = 4 * MiB + 256 * 1024,
                 WS_AEND = 5 * MiB + 256 * 1024, WS_AENDC = WS_AEND + 16384,
                 WS_W1T = 6 * MiB, WS_WOT = WS_W1T + 6 * MiB + 512 * 1024, WS_WGUT = WS_WOT + 2 * MiB, WS_WDT = WS_WGUT + 11 * MiB,
                 WS_T = 31 * MiB, WS_VT = 47 * MiB, WS_Z = 63 * MiB, WS_H = 87 * MiB, WS_XBC = 123 * MiB, WS_ST = 186 * MiB, WS_STC = 234 * MiB,
                 WS_ACAT = WS_H, WS_O1 = 47 * MiB, WS_G = 123 * MiB, WS_END = 240 * MiB;

struct Params { const float* in[21]; float* out; unsigned char* ws; };

typedef float f32x2_t __attribute__((ext_vector_type(2)));
typedef __bf16 bf16x2_t __attribute__((ext_vector_type(2)));
__device__ __forceinline__ unsigned pk2(float lo, float hi) { const f32x2_t v = {lo, hi}; return __builtin_bit_cast(unsigned, __builtin_convertvector(v, bf16x2_t)); }
__device__ __forceinline__ float bflo(unsigned w) { return __uint_as_float(w << 16); }
__device__ __forceinline__ float bfhi(unsigned w) { return __uint_as_float(w & 0xffff0000u); }
__device__ __forceinline__ float silu_f(float x) { return x * __builtin_amdgcn_rcpf(1.0f + __expf(-x)); }
__device__ __forceinline__ float wave_sum(float v) {
#pragma unroll
    for (int o = 1; o < 64; o <<= 1) v += __shfl_xor(v, o);
    return v;
}
#define LDS_WAIT() asm volatile("s_waitcnt lgkmcnt(0)" ::: "memory")

namespace pg8 {
constexpr int BM = 256, BK = 64, HALF = 128, HTB = HALF * BK * 2, NXCD = 8, WGM = 8;
__device__ __forceinline__ int lds_byte(int r, int c) { const int st = (r >> 4) * 2 + (c >> 5), rr = r & 15, cc = c & 31, ob = rr * 64 + cc * 2; return st * 1024 + (ob ^ (((ob >> 9) & 1) << 5)); }
__device__ __forceinline__ void stage_rc(int b, int& R, int& C) { const int st = b / 1024, sb = b % 1024, swz = sb ^ (((sb >> 9) & 1) << 5); R = (st >> 1) * 16 + swz / 64; C = (st & 1) * 32 + (swz % 64) / 2; }
__device__ __forceinline__ int perm32(int rho) { const int n = rho >> 4, i = rho & 15; return 8 * (i >> 2) + 4 * n + (i & 3); }

struct Unit { int pm, pn, ko; };
struct Gemm { const bf16_t* A; const bf16_t* Bt; int lda, ldb, K; };

struct StaticOrder {
    int nM, nN, nwg, G, c;
    __device__ void init(int M, int N, int G_, int c_) { nM = M / BM; nN = N / BM; nwg = nM * nN; G = G_; c = c_; }
    __device__ bool next(int i, Unit& u) const {
        const long L = (long)i * G + c; if (L >= nwg) return false;
        int wgid = (int)L; { const int q = nwg / NXCD, r = nwg % NXCD, xcd = wgid % NXCD, off = wgid / NXCD; wgid = (xcd < r ? xcd * (q + 1) : r * (q + 1) + (xcd - r) * q) + off; }
        const int nig = WGM * nN, gid = wgid / nig, fm = gid * WGM, gsz = (nM - fm) < WGM ? (nM - fm) : WGM;
        u.pm = fm + ((wgid % nig) % gsz); u.pn = (wgid % nig) / gsz; u.ko = 0; return true;
    }
};
struct SplitKOrder {
    int G, c;
    __device__ bool next(int i, Unit& u) const {
        const int L = i * G + c; if (L >= 256) return false;
        u.ko = (L >> 6) * 1024; u.pm = (L >> 3) & 7; u.pn = L & 7; return true;
    }
};

template <class Epi, class Sched>
__device__ __forceinline__ void gemm_phase(ldsp lds, const Gemm g, const Sched& S, const Epi& E) {
    const int tid = threadIdx.x, wid = __builtin_amdgcn_readfirstlane(tid >> 6), lane = tid & 63, wr = wid >> 2, wc = wid & 3, fr = lane & 15, fq = lane >> 4;
    const int nt = g.K / BK;
    unsigned voffA[2], voffB[2];
#pragma unroll
    for (int i = 0; i < 2; ++i) { int R, C; stage_rc(tid * 16 + i * 8192, R, C); const int Rb = Epi::PERM ? ((R & ~31) + perm32(R & 31)) : R;
        voffA[i] = (unsigned)(R * g.lda + C) * 2u; voffB[i] = (unsigned)(Rb * g.ldb + C) * 2u; }
    const size_t kstep = (size_t)(BK * 2);
    const size_t hstepA = (size_t)HALF * g.lda * 2, hstepB = (size_t)HALF * g.ldb * 2, tstepA = 2 * hstepA, tstepB = 2 * hstepB;
    const unsigned ldsw = (unsigned)wid * 1024u;
    const int aoff = lds_byte(wr * 64 + fr, fq * 8), boff = lds_byte(wc * 32 + fr, fq * 8);
#define PG8_SA(b, h) (((b) * 2 + (h)) * HTB)
#define PG8_SB(b, h) ((4 + (b) * 2 + (h)) * HTB)
#define PG8_STAGE(bufoff, gbase, voff) do { _Pragma("unroll") for (int _i = 0; _i < 2; ++_i) \
        __builtin_amdgcn_global_load_lds((const unsigned*)((const char*)(gbase) + (voff)[_i]), (LAS unsigned*)(lds + (bufoff) + ldsw + _i * 8192), 16, 0, 0); } while (0)
#define PG8_LDA(dst, b, h) do { _Pragma("unroll") for (int m = 0; m < 4; ++m) _Pragma("unroll") for (int k = 0; k < 2; ++k) dst[m][k] = *(const LAS bf16x8*)(lds + PG8_SA(b, h) + aoff + m * 2048 + k * 1024); } while (0)
#define PG8_LDB(dst, b, h) do { _Pragma("unroll") for (int n = 0; n < 2; ++n) _Pragma("unroll") for (int k = 0; k < 2; ++k) dst[n][k] = *(const LAS bf16x8*)(lds + PG8_SB(b, h) + boff + n * 2048 + k * 1024); } while (0)
#define PG8_MMA(ai, bj, At, Bt) do { __builtin_amdgcn_s_setprio(1); _Pragma("unroll") for (int m = 0; m < 4; ++m) _Pragma("unroll") for (int n = 0; n < 2; ++n) _Pragma("unroll") for (int k = 0; k < 2; ++k) \
        acc[ai][bj][m][n] = __builtin_amdgcn_mfma_f32_16x16x32_bf16(Bt[n][k], At[m][k], acc[ai][bj][m][n], 0, 0, 0); __builtin_amdgcn_s_setprio(0); } while (0)
#define PG8_WAIT_V(n) asm volatile("s_waitcnt vmcnt(" #n ")" ::: "memory")
#define PG8_WAIT_L(n) asm volatile("s_waitcnt lgkmcnt(" #n ")" ::: "memory")
#define PG8_BAR __builtin_amdgcn_s_barrier()
#define PG8_SCHED __builtin_amdgcn_sched_barrier(0)
    Unit cur, nxt; int ui = 0;
    if (!S.next(0, cur)) return;
    f32x4 acc[2][2][4][2];
#pragma unroll
    for (int a = 0; a < 2; ++a)
#pragma unroll
        for (int b = 0; b < 2; ++b)
#pragma unroll
            for (int m = 0; m < 4; ++m)
#pragma unroll
                for (int n = 0; n < 2; ++n) acc[a][b][m][n] = (f32x4){0.f, 0.f, 0.f, 0.f};
    bf16x8 At[4][2], B0[2][2], B1[2][2];
    const char* cA = (const char*)g.A + (size_t)cur.pm * tstepA + (size_t)cur.ko * 2; const char* cB = (const char*)g.Bt + (size_t)cur.pn * tstepB + (size_t)cur.ko * 2;
    PG8_STAGE(PG8_SB(0, 0), cB, voffB); PG8_STAGE(PG8_SB(0, 1), cB + hstepB, voffB); PG8_STAGE(PG8_SA(0, 0), cA, voffA); PG8_STAGE(PG8_SA(0, 1), cA + hstepA, voffA);
    if (wr == 1) PG8_BAR;
    PG8_WAIT_V(2); PG8_BAR;
    PG8_STAGE(PG8_SB(1, 0), cB + kstep, voffB); PG8_STAGE(PG8_SA(1, 0), cA + kstep, voffA); PG8_STAGE(PG8_SB(1, 1), cB + hstepB + kstep, voffB);
    PG8_WAIT_V(6); PG8_BAR;
    for (;;) {
        const bool has_next = S.next(ui + 1, nxt);
        const char* nA = has_next ? (const char*)g.A + (size_t)nxt.pm * tstepA + (size_t)nxt.ko * 2 : cA; const char* nB = has_next ? (const char*)g.Bt + (size_t)nxt.pn * tstepB + (size_t)nxt.ko * 2 : cB;
        for (int t = 0; t < nt; t += 2) {
            if constexpr (Epi::HOOK) { if (t == Epi::HOOK_T) E.hook(acc, cur, wr, fr); }
            const bool last = (t == nt - 2);
            const char* a1 = cA + (size_t)(t + 1) * kstep;
            const char* a2 = last ? nA : cA + (size_t)(t + 2) * kstep; const char* b2 = last ? nB : cB + (size_t)(t + 2) * kstep;
            const char* a3 = a2 + kstep; const char* b3 = b2 + kstep;
            PG8_LDB(B0, 0, 0); PG8_LDB(B1, 0, 1); PG8_SCHED; PG8_LDA(At, 0, 0); PG8_STAGE(PG8_SA(1, 1), a1 + hstepA, voffA);
            PG8_WAIT_V(8); PG8_WAIT_L(0); PG8_BAR; PG8_MMA(0, 0, At, B0); PG8_MMA(0, 1, At, B1); PG8_BAR; PG8_SCHED;
            PG8_LDA(At, 0, 1); PG8_STAGE(PG8_SB(0, 0), b2, voffB); PG8_STAGE(PG8_SB(0, 1), b2 + hstepB, voffB); PG8_STAGE(PG8_SA(0, 0), a2, voffA);
            PG8_WAIT_V(8); PG8_WAIT_L(0); PG8_BAR; PG8_MMA(1, 0, At, B0); PG8_MMA(1, 1, At, B1); PG8_BAR; PG8_SCHED;
            PG8_LDB(B0, 1, 0); PG8_LDB(B1, 1, 1); PG8_SCHED; PG8_LDA(At, 1, 0); PG8_STAGE(PG8_SA(0, 1), a2 + hstepA, voffA);
            PG8_WAIT_V(8); PG8_WAIT_L(0); PG8_BAR; PG8_MMA(0, 0, At, B0); PG8_MMA(0, 1, At, B1); PG8_BAR; PG8_SCHED;
            PG8_LDA(At, 1, 1); PG8_STAGE(PG8_SB(1, 0), b3, voffB); PG8_STAGE(PG8_SB(1, 1), b3 + hstepB, voffB); PG8_STAGE(PG8_SA(1, 0), a3, voffA);
            PG8_WAIT_V(8); PG8_WAIT_L(0); PG8_BAR; PG8_MMA(1, 0, At, B0); PG8_MMA(1, 1, At, B1); PG8_BAR; PG8_SCHED;
        }
        if (wr == 0) PG8_BAR;
        E(acc, cur, wr, wc, fr, fq);
        if (!has_next) break;
#pragma unroll
        for (int a = 0; a < 2; ++a)
#pragma unroll
            for (int b = 0; b < 2; ++b)
#pragma unroll
                for (int m = 0; m < 4; ++m)
#pragma unroll
                    for (int n = 0; n < 2; ++n) acc[a][b][m][n] = (f32x4){0.f, 0.f, 0.f, 0.f};
        cur = nxt; cA = nA; cB = nB; ++ui;
        if (wr == 1) PG8_BAR;
    }
    PG8_WAIT_V(0);
    PG8_BAR;
    asm volatile("" ::: "memory");
    __syncthreads();
#undef PG8_SA
#undef PG8_SB
#undef PG8_STAGE
#undef PG8_LDA
#undef PG8_LDB
#undef PG8_MMA
#undef PG8_WAIT_V
#undef PG8_WAIT_L
#undef PG8_BAR
#undef PG8_SCHED
}

struct Epi1 {
    static constexpr bool PERM = true, HOOK = false; static constexpr int HOOK_T = -1;
    bf16_t* VT; bf16_t* Z; bf16_t* XR; float* DT;
    __device__ __forceinline__ void hook(f32x4 (&)[2][2][4][2], const Unit&, int, int) const {}
    __device__ __forceinline__ void operator()(const f32x4 (&acc)[2][2][4][2], const Unit& u, int wr, int wc, int fr, int fq) const {
        const int pn = u.pn, pm = u.pm;
        if (pn < 2) {
            if (pm >= 64) return;
            const int b = pm >> 3;
#pragma unroll
            for (int ai = 0; ai < 2; ++ai)
#pragma unroll
                for (int m = 0; m < 4; ++m) { const int t = (pm & 7) * 256 + ai * 128 + wr * 64 + m * 16 + fr;
#pragma unroll
                    for (int bj = 0; bj < 2; ++bj)
#pragma unroll
                        for (int n = 0; n < 2; ++n) { const int cc = 128 * bj + 32 * wc + 8 * fq + 4 * n; bf16_t* p = VT + (size_t)(b * 256 + cc) * 4096 + pn * 2048 + t;
                            const f32x4 v = acc[ai][bj][m][n]; const unsigned w0 = pk2(v[0], v[1]), w1 = pk2(v[2], v[3]);
                            p[0] = (bf16_t)(w0 & 0xffffu); p[4096] = (bf16_t)(w0 >> 16); p[2 * 4096] = (bf16_t)(w1 & 0xffffu); p[3 * 4096] = (bf16_t)(w1 >> 16); } }
        } else if (pn < 12) {
            bf16_t* base; int ld, c0;
            if (pn < 5) { if (pm >= 64) return; base = Z; ld = 768; c0 = 256 * (pn - 2); } else { base = XR; ld = 1792; c0 = 256 * (pn - 5); }
#pragma unroll
            for (int ai = 0; ai < 2; ++ai)
#pragma unroll
                for (int m = 0; m < 4; ++m) { const int row = pm * 256 + ai * 128 + wr * 64 + m * 16 + fr;
#pragma unroll
                    for (int bj = 0; bj < 2; ++bj) { const f32x4 v0 = acc[ai][bj][m][0], v1 = acc[ai][bj][m][1];
                        u32x4 w; w.x = pk2(v0[0], v0[1]); w.y = pk2(v0[2], v0[3]); w.z = pk2(v1[0], v1[1]); w.w = pk2(v1[2], v1[3]);
                        *(u32x4*)(base + (size_t)row * ld + c0 + 128 * bj + 32 * wc + 8 * fq) = w; } }
        } else {
            if (wc == 0 && fq < 3) {
#pragma unroll
                for (int ai = 0; ai < 2; ++ai)
#pragma unroll
                    for (int m = 0; m < 4; ++m) { const int row = pm * 256 + ai * 128 + wr * 64 + m * 16 + fr;
#pragma unroll
                        for (int n = 0; n < 2; ++n) *(f32x4*)(DT + (size_t)row * 24 + 8 * fq + 4 * n) = acc[ai][0][m][n]; }
            }
        }
    }
};
struct EpiFP {
    static constexpr bool PERM = false, HOOK = false; static constexpr int HOOK_T = -1;
    float* FP;
    __device__ __forceinline__ void hook(f32x4 (&)[2][2][4][2], const Unit&, int, int) const {}
    __device__ __forceinline__ void operator()(const f32x4 (&acc)[2][2][4][2], const Unit& u, int wr, int wc, int fr, int fq) const {
        float* base = FP + (size_t)(u.ko >> 10) * 2048 * 2048;
#pragma unroll
        for (int ai = 0; ai < 2; ++ai)
#pragma unroll
            for (int m = 0; m < 4; ++m) { float* rowp = base + (size_t)(u.pm * 256 + ai * 128 + wr * 64 + m * 16 + fr) * 2048 + u.pn * 256 + wc * 32 + 4 * fq;
#pragma unroll
                for (int bj = 0; bj < 2; ++bj)
#pragma unroll
                    for (int n = 0; n < 2; ++n) *(f32x4*)(rowp + bj * 128 + n * 16) = acc[ai][bj][m][n]; }
    }
};
template <bool HK> struct EpiNorm {
    static constexpr bool PERM = true, HOOK = HK; static constexpr int HOOK_T = 12;
    bf16_t* O; float* SSQ; const float* SSQG;
    __device__ __forceinline__ void hook(f32x4 (&acc)[2][2][4][2], const Unit& u, int wr, int fr) const {
#pragma unroll
        for (int ai = 0; ai < 2; ++ai)
#pragma unroll
            for (int m = 0; m < 4; ++m) { const int row = u.pm * 256 + ai * 128 + wr * 64 + m * 16 + fr;
                const f32x4 s = *(const f32x4*)(SSQG + (size_t)row * 4); const float rs = rsqrtf(((s[0] + s[1]) + (s[2] + s[3])) * (1.0f / 768.0f) + EPS);
#pragma unroll
                for (int bj = 0; bj < 2; ++bj)
#pragma unroll
                    for (int n = 0; n < 2; ++n) acc[ai][bj][m][n] *= rs; }
    }
    __device__ __forceinline__ void operator()(const f32x4 (&acc)[2][2][4][2], const Unit& u, int wr, int wc, int fr, int fq) const {
#pragma unroll
        for (int ai = 0; ai < 2; ++ai)
#pragma unroll
            for (int m = 0; m < 4; ++m) { const int row = u.pm * 256 + ai * 128 + wr * 64 + m * 16 + fr; float s = 0.f;
#pragma unroll
                for (int bj = 0; bj < 2; ++bj) { const f32x4 v0 = acc[ai][bj][m][0], v1 = acc[ai][bj][m][1];
                    s += (v0[0] * v0[0] + v0[1] * v0[1]) + (v0[2] * v0[2] + v0[3] * v0[3]) + (v1[0] * v1[0] + v1[1] * v1[1]) + (v1[2] * v1[2] + v1[3] * v1[3]);
                    u32x4 w; w.x = pk2(v0[0], v0[1]); w.y = pk2(v0[2], v0[3]); w.z = pk2(v1[0], v1[1]); w.w = pk2(v1[2], v1[3]);
                    *(u32x4*)(O + (size_t)row * 1024 + u.pn * 256 + 128 * bj + 32 * wc + 8 * fq) = w; }
                s += __shfl_xor(s, 16); s += __shfl_xor(s, 32);
                if (fq == 0) SSQ[(size_t)row * 16 + u.pn * 4 + wc] = s; }
    }
};
struct EpiSwiglu {
    static constexpr bool PERM = true, HOOK = false; static constexpr int HOOK_T = -1;
    bf16_t* Gb;
    __device__ __forceinline__ void hook(f32x4 (&)[2][2][4][2], const Unit&, int, int) const {}
    __device__ __forceinline__ void operator()(const f32x4 (&acc)[2][2][4][2], const Unit& u, int wr, int wc, int fr, int fq) const {
#pragma unroll
        for (int ai = 0; ai < 2; ++ai)
#pragma unroll
            for (int m = 0; m < 4; ++m) { const int row = u.pm * 256 + ai * 128 + wr * 64 + m * 16 + fr;
                float h[8];
#pragma unroll
                for (int n = 0; n < 2; ++n)
#pragma unroll
                    for (int j = 0; j < 4; ++j) h[n * 4 + j] = silu_f(acc[ai][0][m][n][j]) * acc[ai][1][m][n][j];
                u32x4 w; w.x = pk2(h[0], h[1]); w.y = pk2(h[2], h[3]); w.z = pk2(h[4], h[5]); w.w = pk2(h[6], h[7]);
                *(u32x4*)(Gb + (size_t)row * DFF + u.pn * 128 + 32 * wc + 8 * fq) = w; }
    }
};
}

__device__ __forceinline__ void p0_gemv(const Params& P, ldsp lds, int unit) {
    LAS float* s = (LAS float*)lds; LAS float* red = s + 9 * 1024;
    const int tid = threadIdx.x;
    const float* c = P.in[1]; const float* cctx = P.in[3]; const float* w_ada = P.in[4]; const float* b_ada = P.in[5];
    float* mod = (float*)(P.ws + WS_MOD);
    for (int i = tid; i < 9 * 1024; i += NTHR) { const int r = i >> 10, k = i & 1023; const float v = (r < 8) ? c[r * 1024 + k] : cctx[k]; s[i] = v / (1.0f + expf(-v)); }
    __syncthreads();
    const int cgi = tid & 31, kg = tid >> 5, col = unit * 32 + cgi;
    float acc[9];
#pragma unroll
    for (int r = 0; r < 9; ++r) acc[r] = 0.f;
#pragma unroll 4
    for (int kk = 0; kk < 64; ++kk) { const int k = kg * 64 + kk; const float w = w_ada[(size_t)k * 6144 + col];
#pragma unroll
        for (int r = 0; r < 9; ++r) acc[r] += s[r * 1024 + k] * w; }
#pragma unroll
    for (int r = 0; r < 9; ++r) red[(kg * 9 + r) * 32 + cgi] = acc[r];
    __syncthreads();
    if (tid < 288) { const int r = tid >> 5, c2 = tid & 31; float sum = 0.f;
#pragma unroll
        for (int q = 0; q < 16; ++q) sum += red[(q * 9 + r) * 32 + c2];
        mod[r * 6144 + unit * 32 + c2] = sum + b_ada[unit * 32 + c2]; }
    __syncthreads();
}
__device__ __forceinline__ void tr_item(const float* src, int spitch, int ks0, int c0, int nvalid, bf16_t* dst, int dpitch, int n0, int k0, const float* kscale, LAS float* scr, int lane) {
#pragma unroll 8
    for (int i = 0; i < 32; ++i) { const int kk = 2 * i + (lane >> 5), n = lane & 31; float v = 0.f;
        if (n < nvalid) v = src[(size_t)(ks0 + kk) * spitch + c0 + n];
        if (kscale) v *= kscale[kk];
        scr[kk * 33 + n] = v; }
    LDS_WAIT();
    const int c = lane & 7;
#pragma unroll
    for (int j = 0; j < 4; ++j) { const int n = (lane >> 3) + 8 * j; const LAS float* s = scr + (8 * c) * 33 + n;
        u32x4 o; o.x = pk2(s[0 * 33], s[1 * 33]); o.y = pk2(s[2 * 33], s[3 * 33]); o.z = pk2(s[4 * 33], s[5 * 33]); o.w = pk2(s[6 * 33], s[7 * 33]);
        *(u32x4*)(dst + (size_t)(n0 + n) * dpitch + k0 + 8 * c) = o; }
    LDS_WAIT();
}
__device__ __forceinline__ void p0_prep(const Params& P, ldsp lds) {
    const int tid = threadIdx.x, lane = tid & 63, wave = tid >> 6, G = gridDim.x;
    for (int u = blockIdx.x; u < 192; u += G) p0_gemv(P, lds, u);
    LAS float* tab = (LAS float*)lds;
    LAS float* tab64 = (LAS float*)(lds + 8192 + 8 * 8448);
    for (int i = tid; i < 2048; i += NTHR) tab[i] = cospif((float)i * (1.0f / 1024.0f));
    if (tid < 64) tab64[tid] = cospif((float)tid * (1.0f / 32.0f));
    __syncthreads();
    LAS float* scr = (LAS float*)(lds + 8192 + wave * 8448);
    const float* w_in = P.in[10]; const float* g_ssd = P.in[16]; const float* w_out = P.in[17]; const float* w_gate = P.in[18]; const float* w_up = P.in[19]; const float* w_down = P.in[20];
    bf16_t* W1T = (bf16_t*)(P.ws + WS_W1T); bf16_t* WOT = (bf16_t*)(P.ws + WS_WOT); bf16_t* WGUT = (bf16_t*)(P.ws + WS_WGUT); bf16_t* WDT = (bf16_t*)(P.ws + WS_WDT);
    const int gw = blockIdx.x * NWAVE + wave, NGW = G * NWAVE;
    constexpr int I_A = 88 * 16, I_B = 32 * 16, I_C = 176 * 16, I_D = 32 * 44, I_E = 256;
    for (int it = gw; it < I_A + I_B + I_C + I_D + I_E; it += NGW) {
        int r = it;
        if (r < I_E) {
            const int kb = r & 15, g = (r >> 4) & 3, cs = (r >> 6) & 1, half = r >> 7, k = kb * 64 + lane;
            float a[32];
#pragma unroll
            for (int kp = 0; kp < 32; ++kp) a[kp] = 0.f;
#pragma unroll 1
            for (int jc = 0; jc < 8; ++jc) { const f32x4 t0 = *(const f32x4*)(w_in + (size_t)k * INW + g * 64 + jc * 8), t1 = *(const f32x4*)(w_in + (size_t)k * INW + g * 64 + jc * 8 + 4);
                const float v[8] = {t0[0], t0[1], t0[2], t0[3], t1[0], t1[1], t1[2], t1[3]};
#pragma unroll
                for (int kp = 0; kp < 32; ++kp) { const int k2 = half * 32 + kp;
#pragma unroll
                    for (int jj = 0; jj < 8; ++jj) a[kp] += v[jj] * tab64[((jc * 8 + jj) * k2 - 16 * cs) & 63]; } }
#pragma unroll
            for (int kp = 0; kp < 32; ++kp) W1T[(size_t)(cs * 256 + g * 64 + half * 32 + kp) * 1024 + k] = (bf16_t)(pk2(a[kp] * 0.125f, 0.f) & 0xffffu);
            continue; }
        r -= I_E;
        if (r < I_A) { const int nb = 16 + r / 16, kb = r % 16, n0 = nb * 32; int c0 = 0, nv = 32;
            if (n0 < 1280) c0 = 256 + (n0 - 512); else if (n0 < 3072) c0 = 1024 + (n0 - 1280); else if (n0 == 3072) { c0 = 2816; nv = 24; } else nv = 0;
            tr_item(w_in, INW, kb * 64, c0, nv, W1T, 1024, n0, kb * 64, nullptr, scr, lane); continue; }
        r -= I_A;
        if (r < I_B) { const int nb = r / 16, kb = r % 16, k0 = kb * 64;
            if (k0 < 768) tr_item(w_out, 1024, 256 + k0, nb * 32, 32, WOT, 1024, nb * 32, k0, g_ssd + k0, scr, lane);
            else tr_item(w_out, 1024, k0 - 768, nb * 32, 32, WOT, 1024, nb * 32, k0, nullptr, scr, lane);
            continue; }
        r -= I_B;
        if (r < I_C) { const int nb = r / 16, kb = r % 16, n0 = nb * 32, pn = n0 >> 8, bj = (n0 >> 7) & 1, i0 = n0 & 127;
            tr_item(bj ? w_up : w_gate, DFF, kb * 64, 128 * pn + i0, 32, WGUT, 1024, n0, kb * 64, nullptr, scr, lane); continue; }
        r -= I_C;
        { const int nb = r / 44, kb = r % 44; tr_item(w_down, 1024, kb * 64, nb * 32, 32, WDT, DFF, nb * 32, kb * 64, nullptr, scr, lane); }
    }
    bf16_t* T = (bf16_t*)(P.ws + WS_T);
    for (int it = blockIdx.x * NTHR + tid; it < 2048 * 512; it += G * NTHR) {
        const int tp = it >> 9, kk0 = (it & 511) * 8, cs = kk0 >> 11, t0 = kk0 & 2047; float v[8];
#pragma unroll
        for (int e = 0; e < 8; ++e) { const int idx = ((t0 + e) * tp) & 2047; v[e] = (cs ? -tab[(idx - 512) & 2047] : tab[idx]) * 0.02209708691f; }
        u32x4 o; o.x = pk2(v[0], v[1]); o.y = pk2(v[2], v[3]); o.z = pk2(v[4], v[5]); o.w = pk2(v[6], v[7]);
        *(u32x4*)(T + (size_t)tp * 4096 + kk0) = o; }
}

__device__ __forceinline__ void p1_norm(const Params& P) {
    const int tid = threadIdx.x, lane = tid & 63, wave = tid >> 6, G = gridDim.x;
    const int gw = blockIdx.x * NWAVE + wave, NGW = G * NWAVE;
    const float* x = P.in[0]; const float* ctx = P.in[2]; const float* gpre = P.in[6]; const float* mod = (const float*)(P.ws + WS_MOD);
    bf16_t* H = (bf16_t*)(P.ws + WS_H);
    constexpr int R = 3;
    int curb = -1; f32x4 a[4], sft[4];
    const int UPW = (MALL / R + NGW - 1) / NGW;
    for (int i = 0; i < UPW; ++i) { const int u = gw * UPW + i; if (u >= MALL / R) break; const int row0 = u * R;
        f32x4 v[R][4];
#pragma unroll
        for (int r = 0; r < R; ++r) { const int row = row0 + r; const float* src = row < MLAT ? x + (size_t)row * DM : ctx + (size_t)(row - MLAT) * DM;
#pragma unroll
            for (int j = 0; j < 4; ++j) v[r][j] = *(const f32x4*)(src + 4 * lane + 256 * j); }
#pragma unroll
        for (int r = 0; r < R; ++r) { const int row = row0 + r; const int mb = row < MLAT ? (row >> 11) : 8;
            if (mb != curb) { curb = mb;
#pragma unroll
                for (int j = 0; j < 4; ++j) { const int k = 4 * lane + 256 * j; const f32x4 gg = *(const f32x4*)(gpre + k), sc = *(const f32x4*)(mod + mb * 6144 + 1024 + k);
                    a[j] = gg * (sc + 1.0f); sft[j] = *(const f32x4*)(mod + mb * 6144 + k); } }
            float ss = 0.f;
#pragma unroll
            for (int j = 0; j < 4; ++j) ss += (v[r][j][0] * v[r][j][0] + v[r][j][1] * v[r][j][1]) + (v[r][j][2] * v[r][j][2] + v[r][j][3] * v[r][j][3]);
            const float rstd = rsqrtf(wave_sum(ss) * (1.0f / DM) + EPS);
#pragma unroll
            for (int j = 0; j < 4; ++j) { const f32x4 h = v[r][j] * rstd * a[j] + sft[j]; u32x2 w; w.x = pk2(h[0], h[1]); w.y = pk2(h[2], h[3]);
                *(u32x2*)(H + (size_t)row * DM + 4 * lane + 256 * j) = w; } }
    }
}

__device__ __forceinline__ void p3_conv(const Params& P) {
    const int G = gridDim.x;
    const bf16_t* XR = (const bf16_t*)P.out; bf16_t* XBC = (bf16_t*)(P.ws + WS_XBC);
    const float* conv_w = P.in[11]; const float* conv_b = P.in[12];
    for (int it = blockIdx.x * NTHR + threadIdx.x; it < 576 * 224; it += G * NTHR) {
        const int cg8 = it % 224, seg = it / 224, c0 = cg8 * 8, r0 = seg * 32;
        int rs, re; if (r0 < MLAT) { rs = r0 & ~63; re = rs + 64; } else { rs = MLAT + ((r0 - MLAT) & ~255); re = rs + 256; }
        float w[8][7], bias[8];
#pragma unroll
        for (int c = 0; c < 8; ++c) { bias[c] = conv_b[c0 + c];
#pragma unroll
            for (int k = 0; k < 7; ++k) w[c][k] = conv_w[(c0 + c) * 7 + k]; }
        float win[7][8];
#pragma unroll
        for (int k = 0; k < 7; ++k)
#pragma unroll
            for (int c = 0; c < 8; ++c) win[k][c] = 0.f;
#pragma unroll
        for (int half = 0; half < 2; ++half) { constexpr int NL0 = 22, NL1 = 16; const int i0 = half ? NL0 : 0;
            u32x4 raw[NL0];
#pragma unroll
            for (int ii = 0; ii < NL0; ++ii) { raw[ii] = (u32x4){0u, 0u, 0u, 0u}; if (ii < (half ? NL1 : NL0)) { const int src = r0 - 3 + i0 + ii; if (src >= rs && src < re) raw[ii] = *(const u32x4*)(XR + (size_t)src * 1792 + c0); } }
#pragma unroll
            for (int ii = 0; ii < NL0; ++ii) { if (ii < (half ? NL1 : NL0)) { const int i = i0 + ii;
#pragma unroll
                for (int k = 0; k < 6; ++k)
#pragma unroll
                    for (int c = 0; c < 8; ++c) win[k][c] = win[k + 1][c];
                win[6][0] = bflo(raw[ii].x); win[6][1] = bfhi(raw[ii].x); win[6][2] = bflo(raw[ii].y); win[6][3] = bfhi(raw[ii].y); win[6][4] = bflo(raw[ii].z); win[6][5] = bfhi(raw[ii].z); win[6][6] = bflo(raw[ii].w); win[6][7] = bfhi(raw[ii].w);
                if (i >= 6) { float o[8];
#pragma unroll
                    for (int c = 0; c < 8; ++c) { float acc = bias[c];
#pragma unroll
                        for (int k = 0; k < 7; ++k) acc += w[c][k] * win[k][c];
                        o[c] = silu_f(acc); }
                    u32x4 ov; ov.x = pk2(o[0], o[1]); ov.y = pk2(o[2], o[3]); ov.z = pk2(o[4], o[5]); ov.w = pk2(o[6], o[7]);
                    *(u32x4*)(XBC + (size_t)(r0 + i - 6) * 1792 + c0) = ov; } } } }
    }
}

__device__ __forceinline__ float softplus_f(float x) { return x > 20.f ? x : log1pf(expf(x)); }
__device__ __forceinline__ void chunk_scan(const float* DT, size_t rowbase, int col, float bias, float negA, int lane,
                                           float& dt0, float& dt1, float& pi0, float& pi1, float& pe0, float& pe1, float& total) {
    const float r0 = DT[(rowbase + 2 * lane) * 24 + col], r1 = DT[(rowbase + 2 * lane + 1) * 24 + col];
    dt0 = softplus_f(r0 + bias); dt1 = softplus_f(r1 + bias);
    const float a0 = dt0 * negA, a1 = dt1 * negA; float p = a0 + a1;
#pragma unroll
    for (int o = 1; o < 64; o <<= 1) { const float v = __shfl_up(p, o); if (lane >= o) p += v; }
    total = __shfl(p, 63);
    pi1 = p; pi0 = p - a1; pe1 = pi0; pe0 = pi0 - a0;
}
__device__ __forceinline__ void load_transposed(const bf16_t* src, int nch8, LAS bf16_t* dst, int tid) {
    const int nitem = nch8 * 64;
    for (int idx = tid; idx < nitem; idx += NTHR) { const int q = idx >> 5, s2 = (idx & 31) + 32 * (q & 1), ch8 = q >> 1;
        const u32x4 lo = *(const u32x4*)(src + (size_t)(2 * s2) * 1792 + ch8 * 8), hi = *(const u32x4*)(src + (size_t)(2 * s2 + 1) * 1792 + ch8 * 8);
        LAS unsigned* d = (LAS unsigned*)(dst + (ch8 * 8) * 136 + 2 * s2);
        d[0 * 68] = (lo.x & 0xffffu) | (hi.x << 16); d[1 * 68] = (lo.x >> 16) | (hi.x & 0xffff0000u);
        d[2 * 68] = (lo.y & 0xffffu) | (hi.y << 16); d[3 * 68] = (lo.y >> 16) | (hi.y & 0xffff0000u);
        d[4 * 68] = (lo.z & 0xffffu) | (hi.z << 16); d[5 * 68] = (lo.z >> 16) | (hi.z & 0xffff0000u);
        d[6 * 68] = (lo.w & 0xffffu) | (hi.w << 16); d[7 * 68] = (lo.w >> 16) | (hi.w & 0xffff0000u); }
}
__device__ __forceinline__ bf16x8 scale8(bf16x8 x, f32x4 w0, f32x4 w1) {
    const u32x4 u = __builtin_bit_cast(u32x4, x); u32x4 o;
    o.x = pk2(bflo(u.x) * w0[0], bfhi(u.x) * w0[1]); o.y = pk2(bflo(u.y) * w0[2], bfhi(u.y) * w0[3]);
    o.z = pk2(bflo(u.z) * w1[0], bfhi(u.z) * w1[1]); o.w = pk2(bflo(u.w) * w1[2], bfhi(u.w) * w1[3]);
    return __builtin_bit_cast(bf16x8, o);
}

__device__ __forceinline__ void ssd_states_unit(const Params& P, ldsp lds, int u) {
    const int tid = threadIdx.x, lane = tid & 63, wave = __builtin_amdgcn_readfirstlane(tid >> 6), fr = lane & 15, fq = lane >> 4;
    int b, c, g; size_t rowbase; bf16_t* STb; float* AE;
    if (u < 512) { b = u >> 6; c = (u >> 2) & 15; g = u & 3; rowbase = (size_t)b * SEQ + c * 128;
        STb = (bf16_t*)(P.ws + WS_ST) + (size_t)(b * 16 + c) * 24 * 8192; AE = (float*)(P.ws + WS_AEND) + (b * 16 + c) * 24; }
    else { const int v = u - 512; b = v >> 3; c = (v >> 2) & 1; g = v & 3; rowbase = (size_t)MLAT + b * CTXL + c * 128;
        STb = (bf16_t*)(P.ws + WS_STC) + (size_t)(b * 2 + c) * 24 * 8192; AE = (float*)(P.ws + WS_AENDC) + (b * 2 + c) * 24; }
    const bf16_t* XBC = (const bf16_t*)(P.ws + WS_XBC); const float* DT = (const float*)(P.ws + WS_DT);
    LAS bf16_t* BT = (LAS bf16_t*)lds; LAS bf16_t* XT = (LAS bf16_t*)(lds + 34816); LAS float* wl = (LAS float*)(lds + 87040);
    if (wave < 6) { const int r = wave % 3, dir = wave / 3, hd = dir * 12 + g * 3 + r;
        float dt0, dt1, pi0, pi1, pe0, pe1, tot;
        chunk_scan(DT, rowbase, hd, P.in[13][hd], -expf(P.in[14][hd]), lane, dt0, dt1, pi0, pi1, pe0, pe1, tot);
        float w0, w1; if (dir == 0) { w0 = dt0 * __expf(tot - pi0); w1 = dt1 * __expf(tot - pi1); } else { w0 = dt0 * __expf(pe0); w1 = dt1 * __expf(pe1); }
        wl[wave * 128 + 2 * lane] = w0; wl[wave * 128 + 2 * lane + 1] = w1;
        if (lane == 0) AE[hd] = tot; }
    load_transposed(XBC + rowbase * 1792 + 768 + g * 128, 16, BT, tid);
    load_transposed(XBC + rowbase * 1792 + g * 192, 24, XT, tid);
    __syncthreads();
    bf16x8 bfr[4];
#pragma unroll
    for (int kk = 0; kk < 4; ++kk) bfr[kk] = *(const LAS bf16x8*)(BT + (16 * wave + fr) * 136 + kk * 32 + fq * 8);
#pragma unroll 1
    for (int combo = 0; combo < 6; ++combo) { const int r = combo % 3, dir = combo / 3;
        f32x4 acc[4];
#pragma unroll
        for (int mb = 0; mb < 4; ++mb) acc[mb] = (f32x4){0.f, 0.f, 0.f, 0.f};
#pragma unroll
        for (int kk = 0; kk < 4; ++kk) { const f32x4 w0 = *(const LAS f32x4*)(wl + combo * 128 + kk * 32 + fq * 8), w1 = *(const LAS f32x4*)(wl + combo * 128 + kk * 32 + fq * 8 + 4);
#pragma unroll
            for (int mb = 0; mb < 4; ++mb) { const bf16x8 xr = *(const LAS bf16x8*)(XT + (r * 64 + mb * 16 + fr) * 136 + kk * 32 + fq * 8);
                acc[mb] = __builtin_amdgcn_mfma_f32_16x16x32_bf16(bfr[kk], scale8(xr, w0, w1), acc[mb], 0, 0, 0); } }
        bf16_t* dst = STb + (size_t)(dir * 12 + g * 3 + r) * 8192;
#pragma unroll
        for (int mb = 0; mb < 4; ++mb) { u32x2 w; w.x = pk2(acc[mb][0], acc[mb][1]); w.y = pk2(acc[mb][2], acc[mb][3]);
            *(u32x2*)(dst + (mb * 16 + fr) * 128 + 16 * wave + 4 * fq) = w; } }
    __syncthreads();
}

__device__ __forceinline__ void p5_scan(const Params& P) {
    const int G = gridDim.x;
    bf16_t* ST = (bf16_t*)(P.ws + WS_ST); const bf16_t* STC = (const bf16_t*)(P.ws + WS_STC);
    const float* AE = (const float*)(P.ws + WS_AEND); const float* AEC = (const float*)(P.ws + WS_AENDC);
    for (int it = blockIdx.x * NTHR + threadIdx.x; it < NB * 24 * 1024; it += G * NTHR) {
        const int e8 = it & 1023, dh = (it >> 10) % 24, b = it / (24 * 1024), dir = dh / 12;
        u32x4 sc[2], sl[16]; float ac[2], al[16];
#pragma unroll
        for (int ci = 0; ci < 2; ++ci) { const int c = dir ? 1 - ci : ci; ac[ci] = AEC[(b * 2 + c) * 24 + dh]; sc[ci] = *(const u32x4*)(STC + ((size_t)(b * 2 + c) * 24 + dh) * 8192 + e8 * 8); }
#pragma unroll
        for (int ci = 0; ci < 16; ++ci) { const int c = dir ? 15 - ci : ci; al[ci] = AE[(b * 16 + c) * 24 + dh]; sl[ci] = *(const u32x4*)(ST + ((size_t)(b * 16 + c) * 24 + dh) * 8192 + e8 * 8); }
        float h[8];
#pragma unroll
        for (int e = 0; e < 8; ++e) h[e] = 0.f;
#pragma unroll
        for (int ci = 0; ci < 2; ++ci) { const float a = __expf(ac[ci]); const u32x4 s = sc[ci];
            h[0] = a * h[0] + bflo(s.x); h[1] = a * h[1] + bfhi(s.x); h[2] = a * h[2] + bflo(s.y); h[3] = a * h[3] + bfhi(s.y);
            h[4] = a * h[4] + bflo(s.z); h[5] = a * h[5] + bfhi(s.z); h[6] = a * h[6] + bflo(s.w); h[7] = a * h[7] + bfhi(s.w); }
#pragma unroll
        for (int ci = 0; ci < 16; ++ci) { const int c = dir ? 15 - ci : ci; const float a = __expf(al[ci]); const u32x4 s = sl[ci];
            u32x4 o; o.x = pk2(h[0], h[1]); o.y = pk2(h[2], h[3]); o.z = pk2(h[4], h[5]); o.w = pk2(h[6], h[7]);
            *(u32x4*)(ST + ((size_t)(b * 16 + c) * 24 + dh) * 8192 + e8 * 8) = o;
            h[0] = a * h[0] + bflo(s.x); h[1] = a * h[1] + bfhi(s.x); h[2] = a * h[2] + bflo(s.y); h[3] = a * h[3] + bfhi(s.y);
            h[4] = a * h[4] + bflo(s.z); h[5] = a * h[5] + bfhi(s.z); h[6] = a * h[6] + bflo(s.w); h[7] = a * h[7] + bfhi(s.w); }
    }
    const float* FP = (const float*)P.out; bf16_t* ACAT = (bf16_t*)(P.ws + WS_ACAT);
    for (int it = blockIdx.x * NTHR + threadIdx.x; it < 2048 * 256; it += G * NTHR) {
        const int c8 = it & 255, tp = it >> 8, col = c8 * 8, b = col >> 8, cc = col & 255;
        f32x4 s0 = (f32x4){0.f, 0.f, 0.f, 0.f}, s1 = s0;
#pragma unroll
        for (int ks = 0; ks < 4; ++ks) { const float* p = FP + ((size_t)ks * 2048 + tp) * 2048 + col; s0 += *(const f32x4*)p; s1 += *(const f32x4*)(p + 4); }
        u32x4 o; o.x = pk2(s0[0], s0[1]); o.y = pk2(s0[2], s0[3]); o.z = pk2(s1[0], s1[1]); o.w = pk2(s1[2], s1[3]);
        *(u32x4*)(ACAT + ((size_t)b * SEQ + tp) * 1024 + 768 + cc) = o; }
}

__device__ __forceinline__ void ssd_out_unit(const Params& P, ldsp lds, int u) {
    const int tid = threadIdx.x, lane = tid & 63, wave = __builtin_amdgcn_readfirstlane(tid >> 6), fr = lane & 15, fq = lane >> 4;
    const int b = u >> 6, c = (u >> 2) & 15, g = u & 3; const size_t rowbase = (size_t)b * SEQ + c * 128;
    const bf16_t* XBC = (const bf16_t*)(P.ws + WS_XBC); const float* DT = (const float*)(P.ws + WS_DT); const bf16_t* Zb = (const bf16_t*)(P.ws + WS_Z);
    const bf16_t* HIN = (const bf16_t*)(P.ws + WS_ST) + (size_t)(b * 16 + c) * 24 * 8192;
    bf16_t* ACAT = (bf16_t*)(P.ws + WS_ACAT); float* SSQG = (float*)(P.ws + WS_SSQG);
    LAS bf16_t* Cs = (LAS bf16_t*)lds; LAS bf16_t* Bs = (LAS bf16_t*)(lds + 34816); LAS bf16_t* XT = (LAS bf16_t*)(lds + 69632);
    LAS float* af = (LAS float*)(lds + 121856); LAS float* peb = af + 384; LAS float* dtf = peb + 384; LAS float* dtb = dtf + 384; LAS float* ef = dtb + 384; LAS float* eb = ef + 384;
    if (wave < 6) { const int r = wave % 3, dir = wave / 3, hd = dir * 12 + g * 3 + r;
        float dt0, dt1, pi0, pi1, pe0, pe1, tot;
        chunk_scan(DT, rowbase, hd, P.in[13][hd], -expf(P.in[14][hd]), lane, dt0, dt1, pi0, pi1, pe0, pe1, tot);
        const int i0 = r * 128 + 2 * lane;
        if (dir == 0) { af[i0] = pi0; af[i0 + 1] = pi1; dtf[i0] = dt0; dtf[i0 + 1] = dt1; ef[i0] = __expf(pi0); ef[i0 + 1] = __expf(pi1); }
        else { peb[i0] = pe0; peb[i0 + 1] = pe1; dtb[i0] = dt0; dtb[i0 + 1] = dt1; eb[i0] = __expf(tot - pe0); eb[i0 + 1] = __expf(tot - pe1); } }
    for (int idx = tid; idx < 2048; idx += NTHR) { const int row = idx >> 4, ch8 = idx & 15;
        *(LAS u32x4*)(Cs + row * 136 + ch8 * 8) = *(const u32x4*)(XBC + (rowbase + row) * 1792 + 1280 + g * 128 + ch8 * 8);
        *(LAS u32x4*)(Bs + row * 136 + ch8 * 8) = *(const u32x4*)(XBC + (rowbase + row) * 1792 + 768 + g * 128 + ch8 * 8); }
    load_transposed(XBC + rowbase * 1792 + g * 192, 24, XT, tid);
    __syncthreads();
    const int q = 16 * wave + fr;
    bf16x8 cfr[4];
#pragma unroll
    for (int kk = 0; kk < 4; ++kk) cfr[kk] = *(const LAS bf16x8*)(Cs + q * 136 + kk * 32 + fq * 8);
    f32x4 S[8];
#pragma unroll
    for (int sb = 0; sb < 8; ++sb) { S[sb] = (f32x4){0.f, 0.f, 0.f, 0.f};
#pragma unroll
        for (int kk = 0; kk < 4; ++kk) S[sb] = __builtin_amdgcn_mfma_f32_16x16x32_bf16(*(const LAS bf16x8*)(Bs + (sb * 16 + fr) * 136 + kk * 32 + fq * 8), cfr[kk], S[sb], 0, 0, 0); }
    float ssq = 0.f;
#pragma unroll 1
    for (int r = 0; r < 3; ++r) {
        const float afq = af[r * 128 + q], pebq = peb[r * 128 + q];
        f32x4 y[4];
#pragma unroll
        for (int pb = 0; pb < 4; ++pb) y[pb] = (f32x4){0.f, 0.f, 0.f, 0.f};
#pragma unroll
        for (int kk = 0; kk < 4; ++kk) { float mv[8];
#pragma unroll
            for (int hh = 0; hh < 2; ++hh) { const int sb = 2 * kk + hh, s0 = 16 * sb + 4 * fq;
                const f32x4 a4 = *(const LAS f32x4*)(af + r * 128 + s0), p4 = *(const LAS f32x4*)(peb + r * 128 + s0), df4 = *(const LAS f32x4*)(dtf + r * 128 + s0), db4 = *(const LAS f32x4*)(dtb + r * 128 + s0);
#pragma unroll
                for (int j = 0; j < 4; ++j) { const int s = s0 + j;
                    const float cf = (s <= q) ? __expf(afq - a4[j]) * df4[j] : 0.f, cb = (s >= q) ? __expf(p4[j] - pebq) * db4[j] : 0.f;
                    mv[hh * 4 + j] = S[sb][j] * (cf + cb); } }
            u32x4 mw; mw.x = pk2(mv[0], mv[1]); mw.y = pk2(mv[2], mv[3]); mw.z = pk2(mv[4], mv[5]); mw.w = pk2(mv[6], mv[7]);
            const bf16x8 mfr = __builtin_bit_cast(bf16x8, mw);
#pragma unroll
            for (int pb = 0; pb < 4; ++pb) { const LAS bf16_t* xp = XT + (r * 64 + pb * 16 + fr) * 136 + 32 * kk + 4 * fq;
                const u32x2 x0 = *(const LAS u32x2*)xp, x1 = *(const LAS u32x2*)(xp + 16);
                u32x4 xw; xw.x = x0.x; xw.y = x0.y; xw.z = x1.x; xw.w = x1.y;
                y[pb] = __builtin_amdgcn_mfma_f32_16x16x32_bf16(__builtin_bit_cast(bf16x8, xw), mfr, y[pb], 0, 0, 0); } }
#pragma unroll
        for (int dir = 0; dir < 2; ++dir) { const float e = dir ? eb[r * 128 + q] : ef[r * 128 + q];
            const bf16_t* hb = HIN + (size_t)(dir * 12 + g * 3 + r) * 8192;
#pragma unroll
            for (int pb = 0; pb < 4; ++pb) { f32x4 t = (f32x4){0.f, 0.f, 0.f, 0.f};
#pragma unroll
                for (int kk = 0; kk < 4; ++kk) { const bf16x8 hf = *(const bf16x8*)(hb + (pb * 16 + fr) * 128 + kk * 32 + fq * 8);
                    t = __builtin_amdgcn_mfma_f32_16x16x32_bf16(hf, cfr[kk], t, 0, 0, 0); }
                y[pb] += t * e; } }
        const float dsk = P.in[15][g * 3 + r];
#pragma unroll
        for (int pb = 0; pb < 4; ++pb) { const int ch = g * 192 + r * 64 + pb * 16 + 4 * fq;
            const u32x2 xv = *(const u32x2*)(XBC + (rowbase + q) * 1792 + ch), zv = *(const u32x2*)(Zb + (rowbase + q) * 768 + ch);
            const float o0 = (y[pb][0] + bflo(xv.x) * dsk) * silu_f(bflo(zv.x)), o1 = (y[pb][1] + bfhi(xv.x) * dsk) * silu_f(bfhi(zv.x)),
                        o2 = (y[pb][2] + bflo(xv.y) * dsk) * silu_f(bflo(zv.y)), o3 = (y[pb][3] + bfhi(xv.y) * dsk) * silu_f(bfhi(zv.y));
            ssq += (o0 * o0 + o1 * o1) + (o2 * o2 + o3 * o3);
            u32x2 w; w.x = pk2(o0, o1); w.y = pk2(o2, o3);
            *(u32x2*)(ACAT + (rowbase + q) * 1024 + ch) = w; }
    }
    ssq += __shfl_xor(ssq, 16); ssq += __shfl_xor(ssq, 32);
    if (fq == 0) SSQG[(rowbase + q) * 4 + g] = ssq;
    __syncthreads();
}

__device__ __forceinline__ f32x4 ld4bf(const bf16_t* p) { const u32x2 w = *(const u32x2*)p; return (f32x4){bflo(w.x), bfhi(w.x), bflo(w.y), bfhi(w.y)}; }
__device__ __forceinline__ float ssq16(const float* p) { const f32x4 a = *(const f32x4*)p, b = *(const f32x4*)(p + 4), c = *(const f32x4*)(p + 8), d = *(const f32x4*)(p + 12);
    return ((a[0] + a[1]) + (a[2] + a[3])) + ((b[0] + b[1]) + (b[2] + b[3])) + ((c[0] + c[1]) + (c[2] + c[3])) + ((d[0] + d[1]) + (d[2] + d[3])); }
__device__ __forceinline__ void p8_mid(const Params& P) {
    const int tid = threadIdx.x, lane = tid & 63, wave = tid >> 6, G = gridDim.x;
    const int gw = blockIdx.x * NWAVE + wave, NGW = G * NWAVE;
    const float* x = P.in[0]; const float* gpm = P.in[7]; const float* gpf = P.in[8]; const float* mod = (const float*)(P.ws + WS_MOD);
    const bf16_t* O1 = (const bf16_t*)(P.ws + WS_O1); const float* SSQ1 = (const float*)(P.ws + WS_SSQ1); bf16_t* H2 = (bf16_t*)(P.ws + WS_H);
    constexpr int R = 2;
    int curb = -1; f32x4 ga[4], a2[4], s2[4];
    const int UPW = (MLAT / R + NGW - 1) / NGW;
    for (int i = 0; i < UPW; ++i) { const int u = gw * UPW + i; if (u >= MLAT / R) break; const int row0 = u * R, mb = row0 >> 11;
        f32x4 xv[R][4]; u32x2 ov[R][4]; f32x4 sq[R][4];
#pragma unroll
        for (int r = 0; r < R; ++r) { const size_t ro = (size_t)(row0 + r) * DM;
#pragma unroll
            for (int j = 0; j < 4; ++j) { const int k = 4 * lane + 256 * j; xv[r][j] = *(const f32x4*)(x + ro + k); ov[r][j] = *(const u32x2*)(O1 + ro + k); sq[r][j] = *(const f32x4*)(SSQ1 + (size_t)(row0 + r) * 16 + 4 * j); } }
        if (mb != curb) { curb = mb;
#pragma unroll
            for (int j = 0; j < 4; ++j) { const int k = 4 * lane + 256 * j; const float* m = mod + mb * 6144 + k;
                ga[j] = *(const f32x4*)(m + 2048) * *(const f32x4*)(gpm + k); a2[j] = *(const f32x4*)(gpf + k) * (*(const f32x4*)(m + 4096) + 1.0f); s2[j] = *(const f32x4*)(m + 3072); } }
#pragma unroll
        for (int r = 0; r < R; ++r) { const size_t ro = (size_t)(row0 + r) * DM;
            const f32x4 q4 = (sq[r][0] + sq[r][1]) + (sq[r][2] + sq[r][3]);
            const float rstd1 = rsqrtf(((q4[0] + q4[1]) + (q4[2] + q4[3])) * (1.0f / DM) + EPS);
            f32x4 v[4]; float ss = 0.f;
#pragma unroll
            for (int j = 0; j < 4; ++j) { const int k = 4 * lane + 256 * j; const f32x4 o4 = (f32x4){bflo(ov[r][j].x), bfhi(ov[r][j].x), bflo(ov[r][j].y), bfhi(ov[r][j].y)};
                v[j] = xv[r][j] + ga[j] * o4 * rstd1; *(f32x4*)(P.out + ro + k) = v[j]; ss += (v[j][0] * v[j][0] + v[j][1] * v[j][1]) + (v[j][2] * v[j][2] + v[j][3] * v[j][3]); }
            const float rstd2 = rsqrtf(wave_sum(ss) * (1.0f / DM) + EPS);
#pragma unroll
            for (int j = 0; j < 4; ++j) { const f32x4 h = v[j] * rstd2 * a2[j] + s2[j]; u32x2 w; w.x = pk2(h[0], h[1]); w.y = pk2(h[2], h[3]);
                *(u32x2*)(H2 + ro + 4 * lane + 256 * j) = w; } }
    }
}
__device__ __forceinline__ void p11_final(const Params& P) {
    const int tid = threadIdx.x, lane = tid & 63, wave = tid >> 6, G = gridDim.x;
    const int gw = blockIdx.x * NWAVE + wave, NGW = G * NWAVE;
    const float* gpo = P.in[9]; const float* mod = (const float*)(P.ws + WS_MOD);
    const bf16_t* F2 = (const bf16_t*)(P.ws + WS_O1); const float* SSQ2 = (const float*)(P.ws + WS_SSQ2);
    constexpr int R = 4;
    int curb = -1; f32x4 ga[4];
    const int UPW = (MLAT / R + NGW - 1) / NGW;
    for (int i = 0; i < UPW; ++i) { const int u = gw * UPW + i; if (u >= MLAT / R) break; const int row0 = u * R, mb = row0 >> 11;
        f32x4 xv[R][4]; u32x2 ov[R][4]; f32x4 sq[R][4];
#pragma unroll
        for (int r = 0; r < R; ++r) { const size_t ro = (size_t)(row0 + r) * DM;
#pragma unroll
            for (int j = 0; j < 4; ++j) { const int k = 4 * lane + 256 * j; xv[r][j] = *(const f32x4*)(P.out + ro + k); ov[r][j] = *(const u32x2*)(F2 + ro + k); sq[r][j] = *(const f32x4*)(SSQ2 + (size_t)(row0 + r) * 16 + 4 * j); } }
        if (mb != curb) { curb = mb;
#pragma unroll
            for (int j = 0; j < 4; ++j) { const int k = 4 * lane + 256 * j; ga[j] = *(const f32x4*)(mod + mb * 6144 + 5120 + k) * *(const f32x4*)(gpo + k); } }
#pragma unroll
        for (int r = 0; r < R; ++r) { const size_t ro = (size_t)(row0 + r) * DM;
            const f32x4 q4 = (sq[r][0] + sq[r][1]) + (sq[r][2] + sq[r][3]);
            const float rstd = rsqrtf(((q4[0] + q4[1]) + (q4[2] + q4[3])) * (1.0f / DM) + EPS);
#pragma unroll
            for (int j = 0; j < 4; ++j) { const int k = 4 * lane + 256 * j; const f32x4 o4 = (f32x4){bflo(ov[r][j].x), bfhi(ov[r][j].x), bflo(ov[r][j].y), bfhi(ov[r][j].y)};
                *(f32x4*)(P.out + ro + k) = xv[r][j] + ga[j] * o4 * rstd; } }
    }
}

__device__ __forceinline__ void grid_bar(unsigned* cnt, unsigned target) {
    asm volatile("s_waitcnt vmcnt(0) lgkmcnt(0)" ::: "memory");
    __syncthreads();
    if (threadIdx.x == 0) {
        __builtin_amdgcn_fence(__ATOMIC_RELEASE, "agent");
        asm volatile("s_waitcnt vmcnt(0)" ::: "memory");
        __hip_atomic_fetch_add(cnt, 1u, __ATOMIC_RELAXED, __HIP_MEMORY_SCOPE_AGENT);
        while (__hip_atomic_load(cnt, __ATOMIC_RELAXED, __HIP_MEMORY_SCOPE_AGENT) < target) __builtin_amdgcn_s_sleep(1);
        __builtin_amdgcn_fence(__ATOMIC_ACQUIRE, "agent");
        asm volatile("s_waitcnt vmcnt(0)" ::: "memory");
    }
    __syncthreads();
}

__global__ void __launch_bounds__(NTHR, 2) mega(Params P, int lo, int hi) {
    extern __shared__ __attribute__((aligned(16))) unsigned char lds_raw[];
    ldsp lds = (ldsp)lds_raw;
    cg::grid_group grid = cg::this_grid();
    const int G = gridDim.x;
    unsigned char* ws = P.ws;
#ifndef PH_MASK
#define PH_MASK 0xfff
#endif
#define IN(k) (((PH_MASK >> (k)) & 1) && lo <= (k) && (k) < hi)
    unsigned* barcnt = (unsigned*)(ws + WS_BAR);
    if (hi > 1000) grid.sync();
#define SEAM(k) do { if (IN(k) && IN((k) + 1)) grid_bar(barcnt, (unsigned)((k) + 1) * (unsigned)G); } while (0)
    if (IN(0)) p0_prep(P, lds);
    SEAM(0);
    if (IN(1)) p1_norm(P);
    SEAM(1);
    if (IN(2)) { pg8::Gemm g{(const bf16_t*)(ws + WS_H), (const bf16_t*)(ws + WS_W1T), 1024, 1024, 1024}; pg8::StaticOrder S; S.init(MALL, N1, G, (int)blockIdx.x);
        pg8::Epi1 E{(bf16_t*)(ws + WS_VT), (bf16_t*)(ws + WS_Z), (bf16_t*)P.out, (float*)(ws + WS_DT)};
        pg8::gemm_phase(lds, g, S, E); }
    SEAM(2);
    if (IN(3)) p3_conv(P);
    SEAM(3);
    if (IN(4)) { { pg8::Gemm g{(const bf16_t*)(ws + WS_T), (const bf16_t*)(ws + WS_VT), 4096, 4096, 1024}; pg8::SplitKOrder S{G, (int)blockIdx.x};
            pg8::EpiFP E{P.out}; pg8::gemm_phase(lds, g, S, E); }
        for (int u = blockIdx.x; u < 576; u += G) ssd_states_unit(P, lds, u); }
    SEAM(4);
    if (IN(5)) p5_scan(P);
    SEAM(5);
    if (IN(6)) { for (int u = blockIdx.x; u < 512; u += G) ssd_out_unit(P, lds, u); }
    SEAM(6);
    if (IN(7)) { pg8::Gemm g{(const bf16_t*)(ws + WS_ACAT), (const bf16_t*)(ws + WS_WOT), 1024, 1024, 1024}; pg8::StaticOrder S; S.init(MLAT, 1024, G, (int)blockIdx.x);
        pg8::EpiNorm<true> E{(bf16_t*)(ws + WS_O1), (float*)(ws + WS_SSQ1), (const float*)(ws + WS_SSQG)};
        pg8::gemm_phase(lds, g, S, E); }
    SEAM(7);
    if (IN(8)) p8_mid(P);
    SEAM(8);
    if (IN(9)) { pg8::Gemm g{(const bf16_t*)(ws + WS_H), (const bf16_t*)(ws + WS_WGUT), 1024, 1024, 1024}; pg8::StaticOrder S; S.init(MLAT, 2 * DFF, G, (int)blockIdx.x);
        pg8::EpiSwiglu E{(bf16_t*)(ws + WS_G)};
        pg8::gemm_phase(lds, g, S, E); }
    SEAM(9);
    if (IN(10)) { pg8::Gemm g{(const bf16_t*)(ws + WS_G), (const bf16_t*)(ws + WS_WDT), DFF, DFF, DFF}; pg8::StaticOrder S; S.init(MLAT, 1024, G, (int)blockIdx.x);
        pg8::EpiNorm<false> E{(bf16_t*)(ws + WS_O1), (float*)(ws + WS_SSQ2), nullptr};
        pg8::gemm_phase(lds, g, S, E); }
    SEAM(10);
    if (IN(11)) p11_final(P);
#undef IN
#undef SEAM
}


#ifdef PROBE_K
__global__ void dump_bf16(const bf16_t* src, int pitch, int ncols, float* out) {
    for (size_t i = (size_t)blockIdx.x * blockDim.x + threadIdx.x; i < (size_t)MLAT * DM; i += (size_t)gridDim.x * blockDim.x) {
        const int row = (int)(i >> 10), c = (int)(i & 1023);
        out[i] = c < ncols ? __uint_as_float((unsigned)src[(size_t)row * pitch + c] << 16) : 0.f; }
}
#endif
extern "C" void kernel_launch(void* const* d_in, const int* in_sizes, int n_in, void* d_out, int out_size, void* d_ws, size_t ws_size, hipStream_t stream) {
    static int grid = 0;
    if (grid == 0) {
        if (n_in != 21 || out_size != MLAT * DM || ws_size < WS_END) { fprintf(stderr, "kernel_launch: unexpected shapes (n_in %d out %d ws %zu)\n", n_in, out_size, ws_size); grid = -1; return; }
        int dev = 0, cus = 0, per_cu = 0;
        hipGetDevice(&dev); hipDeviceGetAttribute(&cus, hipDeviceAttributeMultiprocessorCount, dev);
        if (hipFuncSetAttribute((const void*)mega, hipFuncAttributeMaxDynamicSharedMemorySize, LDS_BYTES) != hipSuccess) { fprintf(stderr, "kernel_launch: hipFuncSetAttribute failed\n"); grid = -1; return; }
        if (hipOccupancyMaxActiveBlocksPerMultiprocessor(&per_cu, (const void*)mega, NTHR, LDS_BYTES) != hipSuccess || per_cu < 1) { fprintf(stderr, "kernel_launch: occupancy query gave %d\n", per_cu); per_cu = 1; }
        (void)hipGetLastError();
        grid = cus * 1;
    }
    if (grid < 0) return;
    Params p{};
    for (int i = 0; i < 21; ++i) p.in[i] = (const float*)d_in[i];
    p.out = (float*)d_out; p.ws = (unsigned char*)d_ws;
#if MK_LAUNCHES == 1
    (void)hipMemsetAsync((unsigned char*)d_ws + WS_BAR, 0, 256, stream);
    int lo = 0, hi = 12;
    void* args[] = {&p, &lo, &hi};
    hipError_t e = hipLaunchCooperativeKernel((const void*)mega, dim3(grid), dim3(NTHR), args, LDS_BYTES, stream);
    if (e != hipSuccess) fprintf(stderr, "cooperative launch failed: %s (grid %d)\n", hipGetErrorString(e), grid);
#else
#ifdef PROBE_K
    for (int ph = 0; ph <= PROBE_K; ++ph) hipLaunchKernelGGL(mega, dim3(grid), dim3(NTHR), LDS_BYTES, stream, p, ph, ph + 1);
    hipLaunchKernelGGL(dump_bf16, dim3(2048), dim3(256), 0, stream, (const bf16_t*)((unsigned char*)d_ws + PROBE_OFF), PROBE_PITCH, PROBE_NCOLS, (float*)d_out);
#else
    for (int ph = 0; ph < 12; ++ph) hipLaunchKernelGGL(mega, dim3(grid), dim3(NTHR), LDS_BYTES, stream, p, ph, ph + 1);
#endif
#endif
}
```

```cpp
#include <hip/hip_runtime.h>
#include <hip/hip_cooperative_groups.h>
#include <cstdio>
#include <cstdint>
namespace cg = cooperative_groups;

#ifndef MK_LAUNCHES
#define MK_LAUNCHES 1
#endif

#define LAS __attribute__((address_space(3)))
typedef unsigned short bf16_t;
typedef short bf16x8 __attribute__((ext_vector_type(8)));
typedef float f32x4 __attribute__((ext_vector_type(4)));
typedef unsigned u32x4 __attribute__((ext_vector_type(4)));
typedef unsigned u32x2 __attribute__((ext_vector_type(2)));
typedef LAS unsigned char* ldsp;

constexpr int NB = 8, SEQ = 2048, DM = 1024, CTXL = 256;
constexpr int MLAT = NB * SEQ;
constexpr int MCTX = NB * CTXL;
constexpr int MALL = MLAT + MCTX;
constexpr int INW = 2840, DFF = 2816;
constexpr int N1 = 3328;
constexpr float EPS = 1e-6f;
constexpr int NTHR = 512, NWAVE = 8;
constexpr int LDS_BYTES = 143360;

constexpr size_t MiB = 1u << 20;
constexpr size_t WS_BAR = 512 * 1024, WS_MOD = 0, WS_DT = 1 * MiB, WS_SSQG = 3 * MiB, WS_SSQ1 = 3 * MiB + 256 * 1024, WS_SSQ2 = 4 * MiB + 256 * 1024,
                 WS_AEND = 5 * MiB + 256 * 1024, WS_AENDC = WS_AEND + 16384,
                 WS_W1T = 6 * MiB, WS_WOT = WS_W1T + 6 * MiB + 512 * 1024, WS_WGUT = WS_WOT + 2 * MiB, WS_WDT = WS_WGUT + 11 * MiB,
                 WS_T = 31 * MiB, WS_VT = 47 * MiB, WS_Z = 63 * MiB, WS_H = 87 * MiB, WS_XBC = 123 * MiB, WS_ST = 186 * MiB, WS_STC = 234 * MiB,
                 WS_ACAT = WS_H, WS_O1 = 47 * MiB, WS_G = 123 * MiB, WS_END = 240 * MiB;

struct Params { const float* in[21]; float* out; unsigned char* ws; };

typedef float f32x2_t __attribute__((ext_vector_type(2)));
typedef __bf16 bf16x2_t __attribute__((ext_vector_type(2)));
__device__ __forceinline__ unsigned pk2(float lo, float hi) { const f32x2_t v = {lo, hi}; return __builtin_bit_cast(unsigned, __builtin_convertvector(v, bf16x2_t)); }
__device__ __forceinline__ float bflo(unsigned w) { return __uint_as_float(w << 16); }
__device__ __forceinline__ float bfhi(unsigned w) { return __uint_as_float(w & 0xffff0000u); }
__device__ __forceinline__ float silu_f(float x) { return x * __builtin_amdgcn_rcpf(1.0f + __expf(-x)); }
__device__ __forceinline__ float wave_sum(float v) {
#pragma unroll
    for (int o = 1; o < 64; o <<= 1) v += __shfl_xor(v, o);
    return v;
}
#define LDS_WAIT() asm volatile("s_waitcnt lgkmcnt(0)" ::: "memory")

namespace pg8 {
constexpr int BM = 256, BK = 64, HALF = 128, HTB = HALF * BK * 2, NXCD = 8, WGM = 8;
__device__ __forceinline__ int lds_byte(int r, int c) { const int st = (r >> 4) * 2 + (c >> 5), rr = r & 15, cc = c & 31, ob = rr * 64 + cc * 2; return st * 1024 + (ob ^ (((ob >> 9) & 1) << 5)); }
__device__ __forceinline__ void stage_rc(int b, int& R, int& C) { const int st = b / 1024, sb = b % 1024, swz = sb ^ (((sb >> 9) & 1) << 5); R = (st >> 1) * 16 + swz / 64; C = (st & 1) * 32 + (swz % 64) / 2; }
__device__ __forceinline__ int perm32(int rho) { const int n = rho >> 4, i = rho & 15; return 8 * (i >> 2) + 4 * n + (i & 3); }

struct Unit { int pm, pn, ko; };
struct Gemm { const bf16_t* A; const bf16_t* Bt; int lda, ldb, K; };

struct StaticOrder {
    int nM, nN, nwg, G, c;
    __device__ void init(int M, int N, int G_, int c_) { nM = M / BM; nN = N / BM; nwg = nM * nN; G = G_; c = c_; }
    __device__ bool next(int i, Unit& u) const {
        const long L = (long)i * G + c; if (L >= nwg) return false;
        int wgid = (int)L; { const int q = nwg / NXCD, r = nwg % NXCD, xcd = wgid % NXCD, off = wgid / NXCD; wgid = (xcd < r ? xcd * (q + 1) : r * (q + 1) + (xcd - r) * q) + off; }
        const int nig = WGM * nN, gid = wgid / nig, fm = gid * WGM, gsz = (nM - fm) < WGM ? (nM - fm) : WGM;
        u.pm = fm + ((wgid % nig) % gsz); u.pn = (wgid % nig) / gsz; u.ko = 0; return true;
    }
};
struct SplitKOrder {
    int G, c;
    __device__ bool next(int i, Unit& u) const {
        const int L = i * G + c; if (L >= 256) return false;
        u.ko = (L >> 6) * 1024; u.pm = (L >> 3) & 7; u.pn = L & 7; return true;
    }
};

template <class Epi, class Sched>
__device__ __forceinline__ void gemm_phase(ldsp lds, const Gemm g, const Sched& S, const Epi& E) {
    const int tid = threadIdx.x, wid = __builtin_amdgcn_readfirstlane(tid >> 6), lane = tid & 63, wr = wid >> 2, wc = wid & 3, fr = lane & 15, fq = lane >> 4;
    const int nt = g.K / BK;
    unsigned voffA[2], voffB[2];
#pragma unroll
    for (int i = 0; i < 2; ++i) { int R, C; stage_rc(tid * 16 + i * 8192, R, C); const int Rb = Epi::PERM ? ((R & ~31) + perm32(R & 31)) : R;
        voffA[i] = (unsigned)(R * g.lda + C) * 2u; voffB[i] = (unsigned)(Rb * g.ldb + C) * 2u; }
    const size_t kstep = (size_t)(BK * 2);
    const size_t hstepA = (size_t)HALF * g.lda * 2, hstepB = (size_t)HALF * g.ldb * 2, tstepA = 2 * hstepA, tstepB = 2 * hstepB;
    const unsigned ldsw = (unsigned)wid * 1024u;
    const int aoff = lds_byte(wr * 64 + fr, fq * 8), boff = lds_byte(wc * 32 + fr, fq * 8);
#define PG8_SA(b, h) (((b) * 2 + (h)) * HTB)
#define PG8_SB(b, h) ((4 + (b) * 2 + (h)) * HTB)
#define PG8_STAGE(bufoff, gbase, voff) do { _Pragma("unroll") for (int _i = 0; _i < 2; ++_i) \
        __builtin_amdgcn_global_load_lds((const unsigned*)((const char*)(gbase) + (voff)[_i]), (LAS unsigned*)(lds + (bufoff) + ldsw + _i * 8192), 16, 0, 0); } while (0)
#define PG8_LDA(dst, b, h) do { _Pragma("unroll") for (int m = 0; m < 4; ++m) _Pragma("unroll") for (int k = 0; k < 2; ++k) dst[m][k] = *(const LAS bf16x8*)(lds + PG8_SA(b, h) + aoff + m * 2048 + k * 1024); } while (0)
#define PG8_LDB(dst, b, h) do { _Pragma("unroll") for (int n = 0; n < 2; ++n) _Pragma("unroll") for (int k = 0; k < 2; ++k) dst[n][k] = *(const LAS bf16x8*)(lds + PG8_SB(b, h) + boff + n * 2048 + k * 1024); } while (0)
#define PG8_MMA(ai, bj, At, Bt) do { __builtin_amdgcn_s_setprio(1); _Pragma("unroll") for (int m = 0; m < 4; ++m) _Pragma("unroll") for (int n = 0; n < 2; ++n) _Pragma("unroll") for (int k = 0; k < 2; ++k) \
        acc[ai][bj][m][n] = __builtin_amdgcn_mfma_f32_16x16x32_bf16(Bt[n][k], At[m][k], acc[ai][bj][m][n], 0, 0, 0); __builtin_amdgcn_s_setprio(0); } while (0)
#define PG8_WAIT_V(n) asm volatile("s_waitcnt vmcnt(" #n ")" ::: "memory")
#define PG8_WAIT_L(n) asm volatile("s_waitcnt lgkmcnt(" #n ")" ::: "memory")
#define PG8_BAR __builtin_amdgcn_s_barrier()
#define PG8_SCHED __builtin_amdgcn_sched_barrier(0)
    Unit cur, nxt; int ui = 0;
    if (!S.next(0, cur)) return;
    f32x4 acc[2][2][4][2];
#pragma unroll
    for (int a = 0; a < 2; ++a)
#pragma unroll
        for (int b = 0; b < 2; ++b)
#pragma unroll
            for (int m = 0; m < 4; ++m)
#pragma unroll
                for (int n = 0; n < 2; ++n) acc[a][b][m][n] = (f32x4){0.f, 0.f, 0.f, 0.f};
    bf16x8 At[4][2], B0[2][2], B1[2][2];
    const char* cA = (const char*)g.A + (size_t)cur.pm * tstepA + (size_t)cur.ko * 2; const char* cB = (const char*)g.Bt + (size_t)cur.pn * tstepB + (size_t)cur.ko * 2;
    PG8_STAGE(PG8_SB(0, 0), cB, voffB); PG8_STAGE(PG8_SB(0, 1), cB + hstepB, voffB); PG8_STAGE(PG8_SA(0, 0), cA, voffA); PG8_STAGE(PG8_SA(0, 1), cA + hstepA, voffA);
    if (wr == 1) PG8_BAR;
    PG8_WAIT_V(2); PG8_BAR;
    PG8_STAGE(PG8_SB(1, 0), cB + kstep, voffB); PG8_STAGE(PG8_SA(1, 0), cA + kstep, voffA); PG8_STAGE(PG8_SB(1, 1), cB + hstepB + kstep, voffB);
    PG8_WAIT_V(6); PG8_BAR;
    for (;;) {
        const bool has_next = S.next(ui + 1, nxt);
        const char* nA = has_next ? (const char*)g.A + (size_t)nxt.pm * tstepA + (size_t)nxt.ko * 2 : cA; const char* nB = has_next ? (const char*)g.Bt + (size_t)nxt.pn * tstepB + (size_t)nxt.ko * 2 : cB;
        for (int t = 0; t < nt; t += 2) {
            if constexpr (Epi::HOOK) { if (t == Epi::HOOK_T) E.hook(acc, cur, wr, fr); }
            const bool last = (t == nt - 2);
            const char* a1 = cA + (size_t)(t + 1) * kstep;
            const char* a2 = last ? nA : cA + (size_t)(t + 2) * kstep; const char* b2 = last ? nB : cB + (size_t)(t + 2) * kstep;
            const char* a3 = a2 + kstep; const char* b3 = b2 + kstep;
            PG8_LDB(B0, 0, 0); PG8_LDB(B1, 0, 1); PG8_SCHED; PG8_LDA(At, 0, 0); PG8_STAGE(PG8_SA(1, 1), a1 + hstepA, voffA);
            PG8_WAIT_V(8); PG8_WAIT_L(0); PG8_BAR; PG8_MMA(0, 0, At, B0); PG8_MMA(0, 1, At, B1); PG8_BAR; PG8_SCHED;
            PG8_LDA(At, 0, 1); PG8_STAGE(PG8_SB(0, 0), b2, voffB); PG8_STAGE(PG8_SB(0, 1), b2 + hstepB, voffB); PG8_STAGE(PG8_SA(0, 0), a2, voffA);
            PG8_WAIT_V(8); PG8_WAIT_L(0); PG8_BAR; PG8_MMA(1, 0, At, B0); PG8_MMA(1, 1, At, B1); PG8_BAR; PG8_SCHED;
            PG8_LDB(B0, 1, 0); PG8_LDB(B1, 1, 1); PG8_SCHED; PG8_LDA(At, 1, 0); PG8_STAGE(PG8_SA(0, 1), a2 + hstepA, voffA);
            PG8_WAIT_V(8); PG8_WAIT_L(0); PG8_BAR; PG8_MMA(0, 0, At, B0); PG8_MMA(0, 1, At, B1); PG8_BAR; PG8_SCHED;
            PG8_LDA(At, 1, 1); PG8_STAGE(PG8_SB(1, 0), b3, voffB); PG8_STAGE(PG8_SB(1, 1), b3 + hstepB, voffB); PG8_STAGE(PG8_SA(1, 0), a3, voffA);
            PG8_WAIT_V(8); PG8_WAIT_L(0); PG8_BAR; PG8_MMA(1, 0, At, B0); PG8_MMA(1, 1, At, B1); PG8_BAR; PG8_SCHED;
        }
        if (wr == 0) PG8_BAR;
        E(acc, cur, wr, wc, fr, fq);
        if (!has_next) break;
#pragma unroll
        for (int a = 0; a < 2; ++a)
#pragma unroll
            for (int b = 0; b < 2; ++b)
#pragma unroll
                for (int m = 0; m < 4; ++m)
#pragma unroll
                    for (int n = 0; n < 2; ++n) acc[a][b][m][n] = (f32x4){0.f, 0.f, 0.f, 0.f};
        cur = nxt; cA = nA; cB = nB; ++ui;
        if (wr == 1) PG8_BAR;
    }
    PG8_WAIT_V(0);
    PG8_BAR;
    asm volatile("" ::: "memory");
    __syncthreads();
#undef PG8_SA
#undef PG8_SB
#undef PG8_STAGE
#undef PG8_LDA
#undef PG8_LDB
#undef PG8_MMA
#undef PG8_WAIT_V
#undef PG8_WAIT_L
#undef PG8_BAR
#undef PG8_SCHED
}

struct Epi1 {
    static constexpr bool PERM = true, HOOK = false; static constexpr int HOOK_T = -1;
    bf16_t* VT; bf16_t* Z; bf16_t* XR; float* DT;
    __device__ __forceinline__ void hook(f32x4 (&)[2][2][4][2], const Unit&, int, int) const {}
    __device__ __forceinline__ void operator()(const f32x4 (&acc)[2][2][4][2], const Unit& u, int wr, int wc, int fr, int fq) const {
        const int pn = u.pn, pm = u.pm;
        if (pn < 2) {
            if (pm >= 64) return;
            const int b = pm >> 3;
#pragma unroll
            for (int ai = 0; ai < 2; ++ai)
#pragma unroll
                for (int m = 0; m < 4; ++m) { const int t = (pm & 7) * 256 + ai * 128 + wr * 64 + m * 16 + fr;
#pragma unroll
                    for (int bj = 0; bj < 2; ++bj)
#pragma unroll
                        for (int n = 0; n < 2; ++n) { const int cc = 128 * bj + 32 * wc + 8 * fq + 4 * n; bf16_t* p = VT + (size_t)(b * 256 + cc) * 4096 + pn * 2048 + t;
                            const f32x4 v = acc[ai][bj][m][n]; const unsigned w0 = pk2(v[0], v[1]), w1 = pk2(v[2], v[3]);
                            p[0] = (bf16_t)(w0 & 0xffffu); p[4096] = (bf16_t)(w0 >> 16); p[2 * 4096] = (bf16_t)(w1 & 0xffffu); p[3 * 4096] = (bf16_t)(w1 >> 16); } }
        } else if (pn < 12) {
            bf16_t* base; int ld, c0;
            if (pn < 5) { if (pm >= 64) return; base = Z; ld = 768; c0 = 256 * (pn - 2); } else { base = XR; ld = 1792; c0 = 256 * (pn - 5); }
#pragma unroll
            for (int ai = 0; ai < 2; ++ai)
#pragma unroll
                for (int m = 0; m < 4; ++m) { const int row = pm * 256 + ai * 128 + wr * 64 + m * 16 + fr;
#pragma unroll
                    for (int bj = 0; bj < 2; ++bj) { const f32x4 v0 = acc[ai][bj][m][0], v1 = acc[ai][bj][m][1];
                        u32x4 w; w.x = pk2(v0[0], v0[1]); w.y = pk2(v0[2], v0[3]); w.z = pk2(v1[0], v1[1]); w.w = pk2(v1[2], v1[3]);
                        *(u32x4*)(base + (size_t)row * ld + c0 + 128 * bj + 32 * wc + 8 * fq) = w; } }
        } else {
            if (wc == 0 && fq < 3) {
#pragma unroll
                for (int ai = 0; ai < 2; ++ai)
#pragma unroll
                    for (int m = 0; m < 4; ++m) { const int row = pm * 256 + ai * 128 + wr * 64 + m * 16 + fr;
#pragma unroll
                        for (int n = 0; n < 2; ++n) *(f32x4*)(DT + (size_t)row * 24 + 8 * fq + 4 * n) = acc[ai][0][m][n]; }
            }
        }
    }
};
struct EpiFP {
    static constexpr bool PERM = false, HOOK = false; static constexpr int HOOK_T = -1;
    float* FP;
    __device__ __forceinline__ void hook(f32x4 (&)[2][2][4][2], const Unit&, int, int) const {}
    __device__ __forceinline__ void operator()(const f32x4 (&acc)[2][2][4][2], const Unit& u, int wr, int wc, int fr, int fq) const {
        float* base = FP + (size_t)(u.ko >> 10) * 2048 * 2048;
#pragma unroll
        for (int ai = 0; ai < 2; ++ai)
#pragma unroll
            for (int m = 0; m < 4; ++m) { float* rowp = base + (size_t)(u.pm * 256 + ai * 128 + wr * 64 + m * 16 + fr) * 2048 + u.pn * 256 + wc * 32 + 4 * fq;
#pragma unroll
                for (int bj = 0; bj < 2; ++bj)
#pragma unroll
                    for (int n = 0; n < 2; ++n) *(f32x4*)(rowp + bj * 128 + n * 16) = acc[ai][bj][m][n]; }
    }
};
template <bool HK> struct EpiNorm {
    static constexpr bool PERM = true, HOOK = HK; static constexpr int HOOK_T = 12;
    bf16_t* O; float* SSQ; const float* SSQG;
    __device__ __forceinline__ void hook(f32x4 (&acc)[2][2][4][2], const Unit& u, int wr, int fr) const {
        int rbase = u.pm * 256 + wr * 64 + fr;
        asm volatile("" : "+v"(rbase));
#pragma unroll
        for (int ai = 0; ai < 2; ++ai)
#pragma unroll
            for (int m = 0; m < 4; ++m) { const int row = rbase + ai * 128 + m * 16;
                const f32x4 s = *(const f32x4*)(SSQG + (size_t)row * 4); const float rs = rsqrtf(((s[0] + s[1]) + (s[2] + s[3])) * (1.0f / 768.0f) + EPS);
#pragma unroll
                for (int bj = 0; bj < 2; ++bj)
#pragma unroll
                    for (int n = 0; n < 2; ++n) acc[ai][bj][m][n] *= rs;
                asm volatile("" ::: "memory"); }
    }
    __device__ __forceinline__ void operator()(const f32x4 (&acc)[2][2][4][2], const Unit& u, int wr, int wc, int fr, int fq) const {
#pragma unroll
        for (int ai = 0; ai < 2; ++ai)
#pragma unroll
            for (int m = 0; m < 4; ++m) { const int row = u.pm * 256 + ai * 128 + wr * 64 + m * 16 + fr; float s = 0.f;
#pragma unroll
                for (int bj = 0; bj < 2; ++bj) { const f32x4 v0 = acc[ai][bj][m][0], v1 = acc[ai][bj][m][1];
                    s += (v0[0] * v0[0] + v0[1] * v0[1]) + (v0[2] * v0[2] + v0[3] * v0[3]) + (v1[0] * v1[0] + v1[1] * v1[1]) + (v1[2] * v1[2] + v1[3] * v1[3]);
                    u32x4 w; w.x = pk2(v0[0], v0[1]); w.y = pk2(v0[2], v0[3]); w.z = pk2(v1[0], v1[1]); w.w = pk2(v1[2], v1[3]);
                    *(u32x4*)(O + (size_t)row * 1024 + u.pn * 256 + 128 * bj + 32 * wc + 8 * fq) = w; }
                s += __shfl_xor(s, 16); s += __shfl_xor(s, 32);
                if (fq == 0) SSQ[(size_t)row * 16 + u.pn * 4 + wc] = s; }
    }
};
struct EpiSwiglu {
    static constexpr bool PERM = true, HOOK = false; static constexpr int HOOK_T = -1;
    bf16_t* Gb;
    __device__ __forceinline__ void hook(f32x4 (&)[2][2][4][2], const Unit&, int, int) const {}
    __device__ __forceinline__ void operator()(const f32x4 (&acc)[2][2][4][2], const Unit& u, int wr, int wc, int fr, int fq) const {
#pragma unroll
        for (int ai = 0; ai < 2; ++ai)
#pragma unroll
            for (int m = 0; m < 4; ++m) { const int row = u.pm * 256 + ai * 128 + wr * 64 + m * 16 + fr;
                float h[8];
#pragma unroll
                for (int n = 0; n < 2; ++n)
#pragma unroll
                    for (int j = 0; j < 4; ++j) h[n * 4 + j] = silu_f(acc[ai][0][m][n][j]) * acc[ai][1][m][n][j];
                u32x4 w; w.x = pk2(h[0], h[1]); w.y = pk2(h[2], h[3]); w.z = pk2(h[4], h[5]); w.w = pk2(h[6], h[7]);
                *(u32x4*)(Gb + (size_t)row * DFF + u.pn * 128 + 32 * wc + 8 * fq) = w; }
    }
};
}

__device__ __forceinline__ void p0_gemv(const Params& P, ldsp lds, int unit) {
    LAS float* s = (LAS float*)lds; LAS float* red = s + 9 * 1024;
    const int tid = threadIdx.x;
    const float* c = P.in[1]; const float* cctx = P.in[3]; const float* w_ada = P.in[4]; const float* b_ada = P.in[5];
    float* mod = (float*)(P.ws + WS_MOD);
    const int cgi = tid % 24, kg = tid / 24, col = unit * 24 + cgi;
    float w[64];
    if (kg < 16) {
#pragma unroll
        for (int kk = 0; kk < 64; ++kk) w[kk] = w_ada[(size_t)(kg * 64 + kk) * 6144 + col];
    }
    for (int i = tid; i < 9 * 1024; i += NTHR) { const int r = i >> 10, k = i & 1023; const float v = (r < 8) ? c[r * 1024 + k] : cctx[k]; s[i] = v / (1.0f + __expf(-v)); }
    __syncthreads();
    if (kg < 16) {
        float acc[9];
#pragma unroll
        for (int r = 0; r < 9; ++r) acc[r] = 0.f;
#pragma unroll
        for (int k4 = 0; k4 < 16; ++k4)
#pragma unroll
            for (int r = 0; r < 9; ++r) { const f32x4 s4 = *(const LAS f32x4*)(s + r * 1024 + kg * 64 + k4 * 4);
                acc[r] += s4[0] * w[k4 * 4] + s4[1] * w[k4 * 4 + 1] + s4[2] * w[k4 * 4 + 2] + s4[3] * w[k4 * 4 + 3]; }
#pragma unroll
        for (int r = 0; r < 9; ++r) red[(kg * 9 + r) * 24 + cgi] = acc[r];
    }
    __syncthreads();
    if (tid < 216) { const int r = tid / 24, c2 = tid % 24; float sum = 0.f;
#pragma unroll
        for (int q = 0; q < 16; ++q) sum += red[(q * 9 + r) * 24 + c2];
        mod[r * 6144 + unit * 24 + c2] = sum + b_ada[unit * 24 + c2]; }
    __syncthreads();
}
__device__ __forceinline__ void tr_item(const float* src, int spitch, int ks0, int c0, int nvalid, bf16_t* dst, int dpitch, int n0, int k0, const float* kscale, LAS float* scr, int lane) {
    float tv[32];
#pragma unroll
    for (int i = 0; i < 32; ++i) { const int kk = 2 * i + (lane >> 5), n = lane & 31; tv[i] = 0.f;
        if (n < nvalid) tv[i] = src[(size_t)(ks0 + kk) * spitch + c0 + n]; }
#pragma unroll
    for (int i = 0; i < 32; ++i) { const int kk = 2 * i + (lane >> 5), n = lane & 31; float v = tv[i];
        if (kscale) v *= kscale[kk];
        scr[kk * 33 + n] = v; }
    LDS_WAIT();
    const int c = lane & 7;
#pragma unroll
    for (int j = 0; j < 4; ++j) { const int n = (lane >> 3) + 8 * j; const LAS float* s = scr + (8 * c) * 33 + n;
        u32x4 o; o.x = pk2(s[0 * 33], s[1 * 33]); o.y = pk2(s[2 * 33], s[3 * 33]); o.z = pk2(s[4 * 33], s[5 * 33]); o.w = pk2(s[6 * 33], s[7 * 33]);
        *(u32x4*)(dst + (size_t)(n0 + n) * dpitch + k0 + 8 * c) = o; }
    LDS_WAIT();
}
__device__ __forceinline__ void p0_prep(const Params& P, ldsp lds) {
    const int tid = threadIdx.x, lane = tid & 63, wave = tid >> 6, G = gridDim.x;
    for (int u = blockIdx.x; u < 256; u += G) p0_gemv(P, lds, u);
    LAS float* tab = (LAS float*)lds;
    LAS float* tab64 = (LAS float*)(lds + 8192 + 8 * 8448);
    for (int i = tid; i < 2048; i += NTHR) tab[i] = cospif((float)i * (1.0f / 1024.0f));
    if (tid < 64) tab64[tid] = cospif((float)tid * (1.0f / 32.0f));
    __syncthreads();
    LAS float* scr = (LAS float*)(lds + 8192 + wave * 8448);
    const float* w_in = P.in[10]; const float* g_ssd = P.in[16]; const float* w_out = P.in[17]; const float* w_gate = P.in[18]; const float* w_up = P.in[19]; const float* w_down = P.in[20];
    bf16_t* W1T = (bf16_t*)(P.ws + WS_W1T); bf16_t* WOT = (bf16_t*)(P.ws + WS_WOT); bf16_t* WGUT = (bf16_t*)(P.ws + WS_WGUT); bf16_t* WDT = (bf16_t*)(P.ws + WS_WDT);
    const int gw = wave * G + blockIdx.x, NGW = G * NWAVE;
    constexpr int I_A = 88 * 16, I_B = 32 * 16, I_C = 176 * 16, I_D = 32 * 44, I_E = 512;
    for (int it = gw; it < I_A + I_B + I_C + I_D + I_E; it += NGW) {
        int r = it;
        if (r < I_E) {
            const int kb = r & 15, g = (r >> 4) & 3, cs = (r >> 6) & 1, qt = r >> 7, k = kb * 64 + lane;
            float a[16];
#pragma unroll
            for (int kp = 0; kp < 16; ++kp) a[kp] = 0.f;
#pragma unroll 2
            for (int jc = 0; jc < 8; ++jc) { const f32x4 t0 = *(const f32x4*)(w_in + (size_t)k * INW + g * 64 + jc * 8), t1 = *(const f32x4*)(w_in + (size_t)k * INW + g * 64 + jc * 8 + 4);
                const float v[8] = {t0[0], t0[1], t0[2], t0[3], t1[0], t1[1], t1[2], t1[3]};
#pragma unroll
                for (int kp = 0; kp < 16; ++kp) { const int k2 = qt * 16 + kp;
#pragma unroll
                    for (int jj = 0; jj < 8; ++jj) a[kp] += v[jj] * tab64[((jc * 8 + jj) * k2 - 16 * cs) & 63]; } }
#pragma unroll
            for (int kp = 0; kp < 16; ++kp) W1T[(size_t)(cs * 256 + g * 64 + qt * 16 + kp) * 1024 + k] = (bf16_t)(pk2(a[kp] * 0.125f, 0.f) & 0xffffu);
            continue; }
        r -= I_E;
        if (r < I_A) { const int nb = 16 + r / 16, kb = r % 16, n0 = nb * 32; int c0 = 0, nv = 32;
            if (n0 < 1280) c0 = 256 + (n0 - 512); else if (n0 < 3072) c0 = 1024 + (n0 - 1280); else if (n0 == 3072) { c0 = 2816; nv = 24; } else nv = 0;
            tr_item(w_in, INW, kb * 64, c0, nv, W1T, 1024, n0, kb * 64, nullptr, scr, lane); continue; }
        r -= I_A;
        if (r < I_B) { const int nb = r / 16, kb = r % 16, k0 = kb * 64;
            if (k0 < 768) tr_item(w_out, 1024, 256 + k0, nb * 32, 32, WOT, 1024, nb * 32, k0, g_ssd + k0, scr, lane);
            else tr_item(w_out, 1024, k0 - 768, nb * 32, 32, WOT, 1024, nb * 32, k0, nullptr, scr, lane);
            continue; }
        r -= I_B;
        if (r < I_C) { const int nb = r / 16, kb = r % 16, n0 = nb * 32, pn = n0 >> 8, bj = (n0 >> 7) & 1, i0 = n0 & 127;
            tr_item(bj ? w_up : w_gate, DFF, kb * 64, 128 * pn + i0, 32, WGUT, 1024, n0, kb * 64, nullptr, scr, lane); continue; }
        r -= I_C;
        { const int nb = r / 44, kb = r % 44; tr_item(w_down, 1024, kb * 64, nb * 32, 32, WDT, DFF, nb * 32, kb * 64, nullptr, scr, lane); }
    }
    bf16_t* T = (bf16_t*)(P.ws + WS_T);
    for (int it = blockIdx.x * NTHR + tid; it < 2048 * 512; it += G * NTHR) {
        const int tp = it >> 9, kk0 = (it & 511) * 8, cs = kk0 >> 11, t0 = kk0 & 2047; float v[8];
#pragma unroll
        for (int e = 0; e < 8; ++e) { const int idx = ((t0 + e) * tp) & 2047; v[e] = (cs ? -tab[(idx - 512) & 2047] : tab[idx]) * 0.02209708691f; }
        u32x4 o; o.x = pk2(v[0], v[1]); o.y = pk2(v[2], v[3]); o.z = pk2(v[4], v[5]); o.w = pk2(v[6], v[7]);
        *(u32x4*)(T + (size_t)tp * 4096 + kk0) = o; }
}

__device__ __forceinline__ void p1_norm(const Params& P) {
    const int tid = threadIdx.x, lane = tid & 63, wave = tid >> 6, G = gridDim.x;
    const int gw = blockIdx.x * NWAVE + wave, NGW = G * NWAVE;
    const float* x = P.in[0]; const float* ctx = P.in[2]; const float* gpre = P.in[6]; const float* mod = (const float*)(P.ws + WS_MOD);
    bf16_t* H = (bf16_t*)(P.ws + WS_H);
    constexpr int R = 3;
    int curb = -1; f32x4 a[4], sft[4];
    const int UPW = (MALL / R + NGW - 1) / NGW;
    for (int i = 0; i < UPW; ++i) { const int u = gw * UPW + i; if (u >= MALL / R) break; const int row0 = u * R;
        f32x4 v[R][4];
#pragma unroll
        for (int r = 0; r < R; ++r) { const int row = row0 + r; const float* src = row < MLAT ? x + (size_t)row * DM : ctx + (size_t)(row - MLAT) * DM;
#pragma unroll
            for (int j = 0; j < 4; ++j) v[r][j] = *(const f32x4*)(src + 4 * lane + 256 * j); }
#pragma unroll
        for (int r = 0; r < R; ++r) { const int row = row0 + r; const int mb = row < MLAT ? (row >> 11) : 8;
            if (mb != curb) { curb = mb;
#pragma unroll
                for (int j = 0; j < 4; ++j) { const int k = 4 * lane + 256 * j; const f32x4 gg = *(const f32x4*)(gpre + k), sc = *(const f32x4*)(mod + mb * 6144 + 1024 + k);
                    a[j] = gg * (sc + 1.0f); sft[j] = *(const f32x4*)(mod + mb * 6144 + k); } }
            float ss = 0.f;
#pragma unroll
            for (int j = 0; j < 4; ++j) ss += (v[r][j][0] * v[r][j][0] + v[r][j][1] * v[r][j][1]) + (v[r][j][2] * v[r][j][2] + v[r][j][3] * v[r][j][3]);
            const float rstd = rsqrtf(wave_sum(ss) * (1.0f / DM) + EPS);
#pragma unroll
            for (int j = 0; j < 4; ++j) { const f32x4 h = v[r][j] * rstd * a[j] + sft[j]; u32x2 w; w.x = pk2(h[0], h[1]); w.y = pk2(h[2], h[3]);
                *(u32x2*)(H + (size_t)row * DM + 4 * lane + 256 * j) = w; } }
    }
}

__device__ __forceinline__ void p3_conv(const Params& P) {
    const int G = gridDim.x;
    const bf16_t* XR = (const bf16_t*)P.out; bf16_t* XBC = (bf16_t*)(P.ws + WS_XBC);
    const float* conv_w = P.in[11]; const float* conv_b = P.in[12];
    for (int it = blockIdx.x * NTHR + threadIdx.x; it < 576 * 224; it += G * NTHR) {
        const int cg8 = it % 224, seg = it / 224, c0 = cg8 * 8, r0 = seg * 32;
        int rs, re; if (r0 < MLAT) { rs = r0 & ~63; re = rs + 64; } else { rs = MLAT + ((r0 - MLAT) & ~255); re = rs + 256; }
        float w[8][7], bias[8];
#pragma unroll
        for (int c = 0; c < 8; ++c) { bias[c] = conv_b[c0 + c];
#pragma unroll
            for (int k = 0; k < 7; ++k) w[c][k] = conv_w[(c0 + c) * 7 + k]; }
        float win[7][8];
#pragma unroll
        for (int k = 0; k < 7; ++k)
#pragma unroll
            for (int c = 0; c < 8; ++c) win[k][c] = 0.f;
#pragma unroll
        for (int half = 0; half < 2; ++half) { constexpr int NL0 = 22, NL1 = 16; const int i0 = half ? NL0 : 0;
            u32x4 raw[NL0];
#pragma unroll
            for (int ii = 0; ii < NL0; ++ii) { raw[ii] = (u32x4){0u, 0u, 0u, 0u}; if (ii < (half ? NL1 : NL0)) { const int src = r0 - 3 + i0 + ii; if (src >= rs && src < re) raw[ii] = *(const u32x4*)(XR + (size_t)src * 1792 + c0); } }
#pragma unroll
            for (int ii = 0; ii < NL0; ++ii) { if (ii < (half ? NL1 : NL0)) { const int i = i0 + ii;
#pragma unroll
                for (int k = 0; k < 6; ++k)
#pragma unroll
                    for (int c = 0; c < 8; ++c) win[k][c] = win[k + 1][c];
                win[6][0] = bflo(raw[ii].x); win[6][1] = bfhi(raw[ii].x); win[6][2] = bflo(raw[ii].y); win[6][3] = bfhi(raw[ii].y); win[6][4] = bflo(raw[ii].z); win[6][5] = bfhi(raw[ii].z); win[6][6] = bflo(raw[ii].w); win[6][7] = bfhi(raw[ii].w);
                if (i >= 6) { float o[8];
#pragma unroll
                    for (int c = 0; c < 8; ++c) { float acc = bias[c];
#pragma unroll
                        for (int k = 0; k < 7; ++k) acc += w[c][k] * win[k][c];
                        o[c] = silu_f(acc); }
                    u32x4 ov; ov.x = pk2(o[0], o[1]); ov.y = pk2(o[2], o[3]); ov.z = pk2(o[4], o[5]); ov.w = pk2(o[6], o[7]);
                    *(u32x4*)(XBC + (size_t)(r0 + i - 6) * 1792 + c0) = ov; } } } }
    }
}

__device__ __forceinline__ float softplus_f(float x) { return x > 20.f ? x : log1pf(expf(x)); }
__device__ __forceinline__ void chunk_scan(const float* DT, size_t rowbase, int col, float bias, float negA, int lane,
                                           float& dt0, float& dt1, float& pi0, float& pi1, float& pe0, float& pe1, float& total) {
    const float r0 = DT[(rowbase + 2 * lane) * 24 + col], r1 = DT[(rowbase + 2 * lane + 1) * 24 + col];
    dt0 = softplus_f(r0 + bias); dt1 = softplus_f(r1 + bias);
    const float a0 = dt0 * negA, a1 = dt1 * negA; float p = a0 + a1;
#pragma unroll
    for (int o = 1; o < 64; o <<= 1) { const float v = __shfl_up(p, o); if (lane >= o) p += v; }
    total = __shfl(p, 63);
    pi1 = p; pi0 = p - a1; pe1 = pi0; pe0 = pi0 - a0;
}
__device__ __forceinline__ void load_transposed(const bf16_t* src, int nch8, LAS bf16_t* dst, int tid) {
    const int nitem = nch8 * 64;
    for (int idx = tid; idx < nitem; idx += NTHR) { const int q = idx >> 5, s2 = (idx & 31) + 32 * (q & 1), ch8 = q >> 1;
        const u32x4 lo = *(const u32x4*)(src + (size_t)(2 * s2) * 1792 + ch8 * 8), hi = *(const u32x4*)(src + (size_t)(2 * s2 + 1) * 1792 + ch8 * 8);
        LAS unsigned* d = (LAS unsigned*)(dst + (ch8 * 8) * 136 + 2 * s2);
        d[0 * 68] = (lo.x & 0xffffu) | (hi.x << 16); d[1 * 68] = (lo.x >> 16) | (hi.x & 0xffff0000u);
        d[2 * 68] = (lo.y & 0xffffu) | (hi.y << 16); d[3 * 68] = (lo.y >> 16) | (hi.y & 0xffff0000u);
        d[4 * 68] = (lo.z & 0xffffu) | (hi.z << 16); d[5 * 68] = (lo.z >> 16) | (hi.z & 0xffff0000u);
        d[6 * 68] = (lo.w & 0xffffu) | (hi.w << 16); d[7 * 68] = (lo.w >> 16) | (hi.w & 0xffff0000u); }
}
__device__ __forceinline__ bf16x8 scale8(bf16x8 x, f32x4 w0, f32x4 w1) {
    const u32x4 u = __builtin_bit_cast(u32x4, x); u32x4 o;
    o.x = pk2(bflo(u.x) * w0[0], bfhi(u.x) * w0[1]); o.y = pk2(bflo(u.y) * w0[2], bfhi(u.y) * w0[3]);
    o.z = pk2(bflo(u.z) * w1[0], bfhi(u.z) * w1[1]); o.w = pk2(bflo(u.w) * w1[2], bfhi(u.w) * w1[3]);
    return __builtin_bit_cast(bf16x8, o);
}

__device__ __forceinline__ void ssd_states_unit(const Params& P, ldsp lds, int u) {
    const int tid = threadIdx.x, lane = tid & 63, wave = __builtin_amdgcn_readfirstlane(tid >> 6), fr = lane & 15, fq = lane >> 4;
    int b, c, g; size_t rowbase; bf16_t* STb; float* AE;
    if (u < 512) { b = u >> 6; c = (u >> 2) & 15; g = u & 3; rowbase = (size_t)b * SEQ + c * 128;
        STb = (bf16_t*)(P.ws + WS_ST) + (size_t)(b * 16 + c) * 24 * 8192; AE = (float*)(P.ws + WS_AEND) + (b * 16 + c) * 24; }
    else { const int v = u - 512; b = v >> 3; c = (v >> 2) & 1; g = v & 3; rowbase = (size_t)MLAT + b * CTXL + c * 128;
        STb = (bf16_t*)(P.ws + WS_STC) + (size_t)(b * 2 + c) * 24 * 8192; AE = (float*)(P.ws + WS_AENDC) + (b * 2 + c) * 24; }
    const bf16_t* XBC = (const bf16_t*)(P.ws + WS_XBC); const float* DT = (const float*)(P.ws + WS_DT);
    LAS bf16_t* BT = (LAS bf16_t*)lds; LAS bf16_t* XT = (LAS bf16_t*)(lds + 34816); LAS float* wl = (LAS float*)(lds + 87040);
    if (wave < 6) { const int r = wave % 3, dir = wave / 3, hd = dir * 12 + g * 3 + r;
        float dt0, dt1, pi0, pi1, pe0, pe1, tot;
        chunk_scan(DT, rowbase, hd, P.in[13][hd], -expf(P.in[14][hd]), lane, dt0, dt1, pi0, pi1, pe0, pe1, tot);
        float w0, w1; if (dir == 0) { w0 = dt0 * __expf(tot - pi0); w1 = dt1 * __expf(tot - pi1); } else { w0 = dt0 * __expf(pe0); w1 = dt1 * __expf(pe1); }
        wl[wave * 128 + 2 * lane] = w0; wl[wave * 128 + 2 * lane + 1] = w1;
        if (lane == 0) AE[hd] = tot; }
    load_transposed(XBC + rowbase * 1792 + 768 + g * 128, 16, BT, tid);
    load_transposed(XBC + rowbase * 1792 + g * 192, 24, XT, tid);
    __syncthreads();
    bf16x8 bfr[4];
#pragma unroll
    for (int kk = 0; kk < 4; ++kk) bfr[kk] = *(const LAS bf16x8*)(BT + (16 * wave + fr) * 136 + kk * 32 + fq * 8);
#pragma unroll 1
    for (int combo = 0; combo < 6; ++combo) { const int r = combo % 3, dir = combo / 3;
        f32x4 acc[4];
#pragma unroll
        for (int mb = 0; mb < 4; ++mb) acc[mb] = (f32x4){0.f, 0.f, 0.f, 0.f};
#pragma unroll
        for (int kk = 0; kk < 4; ++kk) { const f32x4 w0 = *(const LAS f32x4*)(wl + combo * 128 + kk * 32 + fq * 8), w1 = *(const LAS f32x4*)(wl + combo * 128 + kk * 32 + fq * 8 + 4);
#pragma unroll
            for (int mb = 0; mb < 4; ++mb) { const bf16x8 xr = *(const LAS bf16x8*)(XT + (r * 64 + mb * 16 + fr) * 136 + kk * 32 + fq * 8);
                acc[mb] = __builtin_amdgcn_mfma_f32_16x16x32_bf16(bfr[kk], scale8(xr, w0, w1), acc[mb], 0, 0, 0); } }
        bf16_t* dst = STb + (size_t)(dir * 12 + g * 3 + r) * 8192;
#pragma unroll
        for (int mb = 0; mb < 4; ++mb) { u32x2 w; w.x = pk2(acc[mb][0], acc[mb][1]); w.y = pk2(acc[mb][2], acc[mb][3]);
            *(u32x2*)(dst + (mb * 16 + fr) * 128 + 16 * wave + 4 * fq) = w; } }
    __syncthreads();
}

__device__ __forceinline__ void p5_scan(const Params& P) {
    const int G = gridDim.x;
    bf16_t* ST = (bf16_t*)(P.ws + WS_ST); const bf16_t* STC = (const bf16_t*)(P.ws + WS_STC);
    const float* AE = (const float*)(P.ws + WS_AEND); const float* AEC = (const float*)(P.ws + WS_AENDC);
    for (int it = blockIdx.x * NTHR + threadIdx.x; it < NB * 24 * 1024; it += G * NTHR) {
        const int e8 = it & 1023, dh = (it >> 10) % 24, b = it / (24 * 1024), dir = dh / 12;
        u32x4 sc[2], sl[16]; float ac[2], al[16];
#pragma unroll
        for (int ci = 0; ci < 2; ++ci) { const int c = dir ? 1 - ci : ci; ac[ci] = AEC[(b * 2 + c) * 24 + dh]; sc[ci] = *(const u32x4*)(STC + ((size_t)(b * 2 + c) * 24 + dh) * 8192 + e8 * 8); }
#pragma unroll
        for (int ci = 0; ci < 16; ++ci) { const int c = dir ? 15 - ci : ci; al[ci] = AE[(b * 16 + c) * 24 + dh]; sl[ci] = *(const u32x4*)(ST + ((size_t)(b * 16 + c) * 24 + dh) * 8192 + e8 * 8); }
        float h[8];
#pragma unroll
        for (int e = 0; e < 8; ++e) h[e] = 0.f;
#pragma unroll
        for (int ci = 0; ci < 2; ++ci) { const float a = __expf(ac[ci]); const u32x4 s = sc[ci];
            h[0] = a * h[0] + bflo(s.x); h[1] = a * h[1] + bfhi(s.x); h[2] = a * h[2] + bflo(s.y); h[3] = a * h[3] + bfhi(s.y);
            h[4] = a * h[4] + bflo(s.z); h[5] = a * h[5] + bfhi(s.z); h[6] = a * h[6] + bflo(s.w); h[7] = a * h[7] + bfhi(s.w); }
#pragma unroll
        for (int ci = 0; ci < 16; ++ci) { const int c = dir ? 15 - ci : ci; const float a = __expf(al[ci]); const u32x4 s = sl[ci];
            u32x4 o; o.x = pk2(h[0], h[1]); o.y = pk2(h[2], h[3]); o.z = pk2(h[4], h[5]); o.w = pk2(h[6], h[7]);
            *(u32x4*)(ST + ((size_t)(b * 16 + c) * 24 + dh) * 8192 + e8 * 8) = o;
            h[0] = a * h[0] + bflo(s.x); h[1] = a * h[1] + bfhi(s.x); h[2] = a * h[2] + bflo(s.y); h[3] = a * h[3] + bfhi(s.y);
            h[4] = a * h[4] + bflo(s.z); h[5] = a * h[5] + bfhi(s.z); h[6] = a * h[6] + bflo(s.w); h[7] = a * h[7] + bfhi(s.w); }
    }
    const float* FP = (const float*)P.out; bf16_t* ACAT = (bf16_t*)(P.ws + WS_ACAT);
    for (int it = blockIdx.x * NTHR + threadIdx.x; it < 2048 * 256; it += G * NTHR) {
        const int c8 = it & 255, tp = it >> 8, col = c8 * 8, b = col >> 8, cc = col & 255;
        f32x4 s0 = (f32x4){0.f, 0.f, 0.f, 0.f}, s1 = s0;
#pragma unroll
        for (int ks = 0; ks < 4; ++ks) { const float* p = FP + ((size_t)ks * 2048 + tp) * 2048 + col; s0 += *(const f32x4*)p; s1 += *(const f32x4*)(p + 4); }
        u32x4 o; o.x = pk2(s0[0], s0[1]); o.y = pk2(s0[2], s0[3]); o.z = pk2(s1[0], s1[1]); o.w = pk2(s1[2], s1[3]);
        *(u32x4*)(ACAT + ((size_t)b * SEQ + tp) * 1024 + 768 + cc) = o; }
}

__device__ __forceinline__ void ssd_out_unit(const Params& P, ldsp lds, int u) {
    const int tid = threadIdx.x, lane = tid & 63, wave = __builtin_amdgcn_readfirstlane(tid >> 6), fr = lane & 15, fq = lane >> 4;
    const int b = u >> 6, c = (u >> 2) & 15, g = u & 3; const size_t rowbase = (size_t)b * SEQ + c * 128;
    const bf16_t* XBC = (const bf16_t*)(P.ws + WS_XBC); const float* DT = (const float*)(P.ws + WS_DT); const bf16_t* Zb = (const bf16_t*)(P.ws + WS_Z);
    const bf16_t* HIN = (const bf16_t*)(P.ws + WS_ST) + (size_t)(b * 16 + c) * 24 * 8192;
    bf16_t* ACAT = (bf16_t*)(P.ws + WS_ACAT); float* SSQG = (float*)(P.ws + WS_SSQG);
    LAS bf16_t* Cs = (LAS bf16_t*)lds; LAS bf16_t* Bs = (LAS bf16_t*)(lds + 34816); LAS bf16_t* XT = (LAS bf16_t*)(lds + 69632);
    LAS float* af = (LAS float*)(lds + 121856); LAS float* peb = af + 384; LAS float* dtf = peb + 384; LAS float* dtb = dtf + 384; LAS float* ef = dtb + 384; LAS float* eb = ef + 384;
    if (wave < 6) { const int r = wave % 3, dir = wave / 3, hd = dir * 12 + g * 3 + r;
        float dt0, dt1, pi0, pi1, pe0, pe1, tot;
        chunk_scan(DT, rowbase, hd, P.in[13][hd], -expf(P.in[14][hd]), lane, dt0, dt1, pi0, pi1, pe0, pe1, tot);
        const int i0 = r * 128 + 2 * lane;
        if (dir == 0) { af[i0] = pi0; af[i0 + 1] = pi1; dtf[i0] = dt0; dtf[i0 + 1] = dt1; ef[i0] = __expf(pi0); ef[i0 + 1] = __expf(pi1); }
        else { peb[i0] = pe0; peb[i0 + 1] = pe1; dtb[i0] = dt0; dtb[i0 + 1] = dt1; eb[i0] = __expf(tot - pe0); eb[i0 + 1] = __expf(tot - pe1); } }
    for (int idx = tid; idx < 2048; idx += NTHR) { const int row = idx >> 4, ch8 = idx & 15;
        *(LAS u32x4*)(Cs + row * 136 + ch8 * 8) = *(const u32x4*)(XBC + (rowbase + row) * 1792 + 1280 + g * 128 + ch8 * 8);
        *(LAS u32x4*)(Bs + row * 136 + ch8 * 8) = *(const u32x4*)(XBC + (rowbase + row) * 1792 + 768 + g * 128 + ch8 * 8); }
    load_transposed(XBC + rowbase * 1792 + g * 192, 24, XT, tid);
    __syncthreads();
    const int q = 16 * wave + fr;
    bf16x8 cfr[4];
#pragma unroll
    for (int kk = 0; kk < 4; ++kk) cfr[kk] = *(const LAS bf16x8*)(Cs + q * 136 + kk * 32 + fq * 8);
    f32x4 S[8];
#pragma unroll
    for (int sb = 0; sb < 8; ++sb) { S[sb] = (f32x4){0.f, 0.f, 0.f, 0.f};
#pragma unroll
        for (int kk = 0; kk < 4; ++kk) S[sb] = __builtin_amdgcn_mfma_f32_16x16x32_bf16(*(const LAS bf16x8*)(Bs + (sb * 16 + fr) * 136 + kk * 32 + fq * 8), cfr[kk], S[sb], 0, 0, 0); }
    float ssq = 0.f;
#pragma unroll 1
    for (int r = 0; r < 3; ++r) {
        const float afq = af[r * 128 + q], pebq = peb[r * 128 + q];
        f32x4 y[4];
#pragma unroll
        for (int pb = 0; pb < 4; ++pb) y[pb] = (f32x4){0.f, 0.f, 0.f, 0.f};
#pragma unroll
        for (int kk = 0; kk < 4; ++kk) { float mv[8];
#pragma unroll
            for (int hh = 0; hh < 2; ++hh) { const int sb = 2 * kk + hh, s0 = 16 * sb + 4 * fq;
                const f32x4 a4 = *(const LAS f32x4*)(af + r * 128 + s0), p4 = *(const LAS f32x4*)(peb + r * 128 + s0), df4 = *(const LAS f32x4*)(dtf + r * 128 + s0), db4 = *(const LAS f32x4*)(dtb + r * 128 + s0);
#pragma unroll
                for (int j = 0; j < 4; ++j) { const int s = s0 + j;
                    const float cf = (s <= q) ? __expf(afq - a4[j]) * df4[j] : 0.f, cb = (s >= q) ? __expf(p4[j] - pebq) * db4[j] : 0.f;
                    mv[hh * 4 + j] = S[sb][j] * (cf + cb); } }
            u32x4 mw; mw.x = pk2(mv[0], mv[1]); mw.y = pk2(mv[2], mv[3]); mw.z = pk2(mv[4], mv[5]); mw.w = pk2(mv[6], mv[7]);
            const bf16x8 mfr = __builtin_bit_cast(bf16x8, mw);
#pragma unroll
            for (int pb = 0; pb < 4; ++pb) { const LAS bf16_t* xp = XT + (r * 64 + pb * 16 + fr) * 136 + 32 * kk + 4 * fq;
                const u32x2 x0 = *(const LAS u32x2*)xp, x1 = *(const LAS u32x2*)(xp + 16);
                u32x4 xw; xw.x = x0.x; xw.y = x0.y; xw.z = x1.x; xw.w = x1.y;
                y[pb] = __builtin_amdgcn_mfma_f32_16x16x32_bf16(__builtin_bit_cast(bf16x8, xw), mfr, y[pb], 0, 0, 0); } }
#pragma unroll
        for (int dir = 0; dir < 2; ++dir) { const float e = dir ? eb[r * 128 + q] : ef[r * 128 + q];
            const bf16_t* hb = HIN + (size_t)(dir * 12 + g * 3 + r) * 8192;
#pragma unroll
            for (int pb = 0; pb < 4; ++pb) { f32x4 t = (f32x4){0.f, 0.f, 0.f, 0.f};
#pragma unroll
                for (int kk = 0; kk < 4; ++kk) { const bf16x8 hf = *(const bf16x8*)(hb + (pb * 16 + fr) * 128 + kk * 32 + fq * 8);
                    t = __builtin_amdgcn_mfma_f32_16x16x32_bf16(hf, cfr[kk], t, 0, 0, 0); }
                y[pb] += t * e; } }
        const float dsk = P.in[15][g * 3 + r];
#pragma unroll
        for (int pb = 0; pb < 4; ++pb) { const int ch = g * 192 + r * 64 + pb * 16 + 4 * fq;
            const u32x2 xv = *(const u32x2*)(XBC + (rowbase + q) * 1792 + ch), zv = *(const u32x2*)(Zb + (rowbase + q) * 768 + ch);
            const float o0 = (y[pb][0] + bflo(xv.x) * dsk) * silu_f(bflo(zv.x)), o1 = (y[pb][1] + bfhi(xv.x) * dsk) * silu_f(bfhi(zv.x)),
                        o2 = (y[pb][2] + bflo(xv.y) * dsk) * silu_f(bflo(zv.y)), o3 = (y[pb][3] + bfhi(xv.y) * dsk) * silu_f(bfhi(zv.y));
            ssq += (o0 * o0 + o1 * o1) + (o2 * o2 + o3 * o3);
            u32x2 w; w.x = pk2(o0, o1); w.y = pk2(o2, o3);
            *(u32x2*)(ACAT + (rowbase + q) * 1024 + ch) = w; }
    }
    ssq += __shfl_xor(ssq, 16); ssq += __shfl_xor(ssq, 32);
    if (fq == 0) SSQG[(rowbase + q) * 4 + g] = ssq;
    __syncthreads();
}

__device__ __forceinline__ f32x4 ld4bf(const bf16_t* p) { const u32x2 w = *(const u32x2*)p; return (f32x4){bflo(w.x), bfhi(w.x), bflo(w.y), bfhi(w.y)}; }
__device__ __forceinline__ float ssq16(const float* p) { const f32x4 a = *(const f32x4*)p, b = *(const f32x4*)(p + 4), c = *(const f32x4*)(p + 8), d = *(const f32x4*)(p + 12);
    return ((a[0] + a[1]) + (a[2] + a[3])) + ((b[0] + b[1]) + (b[2] + b[3])) + ((c[0] + c[1]) + (c[2] + c[3])) + ((d[0] + d[1]) + (d[2] + d[3])); }
__device__ __forceinline__ void p8_mid(const Params& P) {
    const int tid = threadIdx.x, lane = tid & 63, wave = tid >> 6, G = gridDim.x;
    const int gw = blockIdx.x * NWAVE + wave, NGW = G * NWAVE;
    const float* x = P.in[0]; const float* gpm = P.in[7]; const float* gpf = P.in[8]; const float* mod = (const float*)(P.ws + WS_MOD);
    const bf16_t* O1 = (const bf16_t*)(P.ws + WS_O1); const float* SSQ1 = (const float*)(P.ws + WS_SSQ1); bf16_t* H2 = (bf16_t*)(P.ws + WS_H);
    constexpr int R = 2;
    int curb = -1; f32x4 ga[4], a2[4], s2[4];
    const int UPW = (MLAT / R + NGW - 1) / NGW;
    for (int i = 0; i < UPW; ++i) { const int u = gw * UPW + i; if (u >= MLAT / R) break; const int row0 = u * R, mb = row0 >> 11;
        f32x4 xv[R][4]; u32x2 ov[R][4]; f32x4 sq[R][4];
#pragma unroll
        for (int r = 0; r < R; ++r) { const size_t ro = (size_t)(row0 + r) * DM;
#pragma unroll
            for (int j = 0; j < 4; ++j) { const int k = 4 * lane + 256 * j; xv[r][j] = *(const f32x4*)(x + ro + k); ov[r][j] = *(const u32x2*)(O1 + ro + k); sq[r][j] = *(const f32x4*)(SSQ1 + (size_t)(row0 + r) * 16 + 4 * j); } }
        if (mb != curb) { curb = mb;
#pragma unroll
            for (int j = 0; j < 4; ++j) { const int k = 4 * lane + 256 * j; const float* m = mod + mb * 6144 + k;
                ga[j] = *(const f32x4*)(m + 2048) * *(const f32x4*)(gpm + k); a2[j] = *(const f32x4*)(gpf + k) * (*(const f32x4*)(m + 4096) + 1.0f); s2[j] = *(const f32x4*)(m + 3072); } }
#pragma unroll
        for (int r = 0; r < R; ++r) { const size_t ro = (size_t)(row0 + r) * DM;
            const f32x4 q4 = (sq[r][0] + sq[r][1]) + (sq[r][2] + sq[r][3]);
            const float rstd1 = rsqrtf(((q4[0] + q4[1]) + (q4[2] + q4[3])) * (1.0f / DM) + EPS);
            f32x4 v[4]; float ss = 0.f;
#pragma unroll
            for (int j = 0; j < 4; ++j) { const int k = 4 * lane + 256 * j; const f32x4 o4 = (f32x4){bflo(ov[r][j].x), bfhi(ov[r][j].x), bflo(ov[r][j].y), bfhi(ov[r][j].y)};
                v[j] = xv[r][j] + ga[j] * o4 * rstd1; *(f32x4*)(P.out + ro + k) = v[j]; ss += (v[j][0] * v[j][0] + v[j][1] * v[j][1]) + (v[j][2] * v[j][2] + v[j][3] * v[j][3]); }
            const float rstd2 = rsqrtf(wave_sum(ss) * (1.0f / DM) + EPS);
#pragma unroll
            for (int j = 0; j < 4; ++j) { const f32x4 h = v[j] * rstd2 * a2[j] + s2[j]; u32x2 w; w.x = pk2(h[0], h[1]); w.y = pk2(h[2], h[3]);
                *(u32x2*)(H2 + ro + 4 * lane + 256 * j) = w; } }
    }
}
__device__ __forceinline__ void p11_final(const Params& P) {
    const int tid = threadIdx.x, lane = tid & 63, wave = tid >> 6, G = gridDim.x;
    const int gw = blockIdx.x * NWAVE + wave, NGW = G * NWAVE;
    const float* gpo = P.in[9]; const float* mod = (const float*)(P.ws + WS_MOD);
    const bf16_t* F2 = (const bf16_t*)(P.ws + WS_O1); const float* SSQ2 = (const float*)(P.ws + WS_SSQ2);
    constexpr int R = 4;
    int curb = -1; f32x4 ga[4];
    const int UPW = (MLAT / R + NGW - 1) / NGW;
    for (int i = 0; i < UPW; ++i) { const int u = gw * UPW + i; if (u >= MLAT / R) break; const int row0 = u * R, mb = row0 >> 11;
        f32x4 xv[R][4]; u32x2 ov[R][4]; f32x4 sq[R][4];
#pragma unroll
        for (int r = 0; r < R; ++r) { const size_t ro = (size_t)(row0 + r) * DM;
#pragma unroll
            for (int j = 0; j < 4; ++j) { const int k = 4 * lane + 256 * j; xv[r][j] = *(const f32x4*)(P.out + ro + k); ov[r][j] = *(const u32x2*)(F2 + ro + k); sq[r][j] = *(const f32x4*)(SSQ2 + (size_t)(row0 + r) * 16 + 4 * j); } }
        if (mb != curb) { curb = mb;
#pragma unroll
            for (int j = 0; j < 4; ++j) { const int k = 4 * lane + 256 * j; ga[j] = *(const f32x4*)(mod + mb * 6144 + 5120 + k) * *(const f32x4*)(gpo + k); } }
#pragma unroll
        for (int r = 0; r < R; ++r) { const size_t ro = (size_t)(row0 + r) * DM;
            const f32x4 q4 = (sq[r][0] + sq[r][1]) + (sq[r][2] + sq[r][3]);
            const float rstd = rsqrtf(((q4[0] + q4[1]) + (q4[2] + q4[3])) * (1.0f / DM) + EPS);
#pragma unroll
            for (int j = 0; j < 4; ++j) { const int k = 4 * lane + 256 * j; const f32x4 o4 = (f32x4){bflo(ov[r][j].x), bfhi(ov[r][j].x), bflo(ov[r][j].y), bfhi(ov[r][j].y)};
                *(f32x4*)(P.out + ro + k) = xv[r][j] + ga[j] * o4 * rstd; } }
    }
}

#define XB_TMO      128
#define XB_XCNT(j)  (256  + 64 * (j))
#define XB_XSUB(j)  (1280 + 64 * (j))
#define XB_XGEN(j)  (2304 + 64 * (j))
#define XB_TOP      3328
#define XB_TOPGEN   3392
#define XCD_BAR_WORDS 3456
#define XB_SPIN_CAP (1u << 18)
__device__ __forceinline__ unsigned xb_ld(unsigned* p)              { return __hip_atomic_load(p, __ATOMIC_RELAXED, __HIP_MEMORY_SCOPE_AGENT); }
__device__ __forceinline__ unsigned xb_add(unsigned* p, unsigned v) { return __hip_atomic_fetch_add(p, v, __ATOMIC_RELAXED, __HIP_MEMORY_SCOPE_AGENT); }
__device__ __forceinline__ unsigned xb_xcc_id() { return (unsigned)__builtin_amdgcn_s_getreg((3 << 11) | 20) & 0xFu; }
#define XB_SPIN(cond, bar) do { unsigned _sp = 0; while (cond) { __builtin_amdgcn_s_sleep(1); \
    if ((++_sp & 255u) == 0u) { if (xb_ld(&(bar)[XB_TMO])) break; if (_sp > XB_SPIN_CAP) { atomicAdd(&(bar)[XB_TMO], 1u); break; } } } } while (0)
struct XcdBarrier { unsigned* bar; unsigned x; volatile LAS unsigned* st; };
__device__ __forceinline__ XcdBarrier xcd_barrier_post(unsigned* bar, volatile LAS unsigned* st) {
    XcdBarrier b; b.bar = bar; b.x = xb_xcc_id(); b.st = st;
    if (threadIdx.x == 0) (void)xb_add(&bar[XB_XCNT(b.x)], 1u);
    return b;
}
__device__ __forceinline__ void xcd_barrier_complete(unsigned* bar, unsigned x, unsigned& nloc, unsigned& nx) {
    const unsigned G = gridDim.x * gridDim.y * gridDim.z;
    unsigned sum, cnt, mine, sp = 0u;
    for (;;) {
        sum = 0u; cnt = 0u; mine = 0u;
#pragma unroll
        for (unsigned j = 0; j < 16; ++j) { const unsigned c = xb_ld(&bar[XB_XCNT(j)]); sum += c; cnt += (c > 0u) ? 1u : 0u; mine = (j == x) ? c : mine; }
        if (sum == G) break;
        __builtin_amdgcn_s_sleep(1);
        if ((++sp & 255u) == 0u) { if (xb_ld(&bar[XB_TMO])) break; if (sp > XB_SPIN_CAP) { atomicAdd(&bar[XB_TMO], 1u); break; } }
    }
    nloc = mine > 0u ? mine : 1u; nx = cnt > 0u ? cnt : 1u;
}
__device__ __forceinline__ void xcd_barrier(const XcdBarrier& b) {
    asm volatile("s_waitcnt vmcnt(0)" ::: "memory");
    __syncthreads();
    if (threadIdx.x == 0) {
        unsigned* bar = b.bar;
        __builtin_amdgcn_s_waitcnt(0);
        unsigned nloc = b.st[0], nx = b.st[1];
        if (nloc == 0u) { xcd_barrier_complete(bar, b.x, nloc, nx); b.st[0] = nloc; b.st[1] = nx; }
        const unsigned old = xb_add(&bar[XB_XSUB(b.x)], 1u);
        const unsigned gen = old / nloc;
        if (old + 1u == (gen + 1u) * nloc) {
            __builtin_amdgcn_fence(__ATOMIC_RELEASE, "agent");
            asm volatile("s_waitcnt vmcnt(0)" ::: "memory");
            const unsigned og = xb_add(&bar[XB_TOP], 1u);
            const unsigned tg = og / nx;
            if (og + 1u == (tg + 1u) * nx) xb_add(&bar[XB_TOPGEN], 1u);
            else XB_SPIN(xb_ld(&bar[XB_TOPGEN]) == tg, bar);
            __builtin_amdgcn_fence(__ATOMIC_ACQUIRE, "agent");
            xb_add(&bar[XB_XGEN(b.x)], 1u);
            asm volatile("s_waitcnt vmcnt(0)" ::: "memory");
        } else {
            XB_SPIN(xb_ld(&bar[XB_XGEN(b.x)]) == gen, bar);
            __builtin_amdgcn_fence(__ATOMIC_ACQUIRE, "agent");
            asm volatile("s_waitcnt vmcnt(0)" ::: "memory");
        }
    }
    __syncthreads();
}

__global__ void __launch_bounds__(NTHR, 2) mega(Params P, int lo, int hi) {
    extern __shared__ __attribute__((aligned(16))) unsigned char lds_raw[];
    ldsp lds = (ldsp)lds_raw;
    cg::grid_group grid = cg::this_grid();
    const int G = gridDim.x;
    unsigned char* ws = P.ws;
#ifndef PH_MASK
#define PH_MASK 0xfff
#endif
#define IN(k) (((PH_MASK >> (k)) & 1) && lo <= (k) && (k) < hi)
    volatile LAS unsigned* bst = (volatile LAS unsigned*)(lds + LDS_BYTES - 16);
    if (threadIdx.x < 4) bst[threadIdx.x] = 0u;
    __syncthreads();
    (void)xcd_barrier_post((unsigned*)(ws + WS_BAR), bst);
    if (hi > 1000) grid.sync();
#define SEAM(k) do { if (IN(k) && IN((k) + 1)) { XcdBarrier xb_; xb_.bar = (unsigned*)(P.ws + WS_BAR); xb_.x = xb_xcc_id(); xb_.st = (volatile LAS unsigned*)(lds + LDS_BYTES - 16); xcd_barrier(xb_); } } while (0)
    if (IN(0)) p0_prep(P, lds);
    SEAM(0);
    if (IN(1)) p1_norm(P);
    SEAM(1);
    if (IN(2)) { pg8::Gemm g{(const bf16_t*)(ws + WS_H), (const bf16_t*)(ws + WS_W1T), 1024, 1024, 1024}; pg8::StaticOrder S; S.init(MALL, N1, G, (int)blockIdx.x);
        pg8::Epi1 E{(bf16_t*)(ws + WS_VT), (bf16_t*)(ws + WS_Z), (bf16_t*)P.out, (float*)(ws + WS_DT)};
        pg8::gemm_phase(lds, g, S, E); }
    SEAM(2);
    if (IN(3)) p3_conv(P);
    SEAM(3);
    if (IN(4)) { { pg8::Gemm g{(const bf16_t*)(ws + WS_T), (const bf16_t*)(ws + WS_VT), 4096, 4096, 1024}; pg8::SplitKOrder S{G, (int)blockIdx.x};
            pg8::EpiFP E{P.out}; pg8::gemm_phase(lds, g, S, E); }
        for (int u = blockIdx.x; u < 576; u += G) ssd_states_unit(P, lds, u); }
    SEAM(4);
    if (IN(5)) p5_scan(P);
    SEAM(5);
    if (IN(6)) { for (int u = blockIdx.x; u < 512; u += G) ssd_out_unit(P, lds, u); }
    SEAM(6);
    if (IN(7)) { pg8::Gemm g{(const bf16_t*)(ws + WS_ACAT), (const bf16_t*)(ws + WS_WOT), 1024, 1024, 1024}; pg8::StaticOrder S; S.init(MLAT, 1024, G, (int)blockIdx.x);
        pg8::EpiNorm<true> E{(bf16_t*)(ws + WS_O1), (float*)(ws + WS_SSQ1), (const float*)(ws + WS_SSQG)};
        pg8::gemm_phase(lds, g, S, E); }
    SEAM(7);
    if (IN(8)) p8_mid(P);
    SEAM(8);
    if (IN(9)) { pg8::Gemm g{(const bf16_t*)(ws + WS_H), (const bf16_t*)(ws + WS_WGUT), 1024, 1024, 1024}; pg8::StaticOrder S; S.init(MLAT, 2 * DFF, G, (int)blockIdx.x);
        pg8::EpiSwiglu E{(bf16_t*)(ws + WS_G)};
        pg8::gemm_phase(lds, g, S, E); }
    SEAM(9);
    if (IN(10)) { pg8::Gemm g{(const bf16_t*)(ws + WS_G), (const bf16_t*)(ws + WS_WDT), DFF, DFF, DFF}; pg8::StaticOrder S; S.init(MLAT, 1024, G, (int)blockIdx.x);
        pg8::EpiNorm<false> E{(bf16_t*)(ws + WS_O1), (float*)(ws + WS_SSQ2), nullptr};
        pg8::gemm_phase(lds, g, S, E); }
    SEAM(10);
    if (IN(11)) p11_final(P);
#undef IN
#undef SEAM
}


#ifdef PROBE_K
__global__ void dump_bf16(const bf16_t* src, int pitch, int ncols, float* out) {
    for (size_t i = (size_t)blockIdx.x * blockDim.x + threadIdx.x; i < (size_t)MLAT * DM; i += (size_t)gridDim.x * blockDim.x) {
        const int row = (int)(i >> 10), c = (int)(i & 1023);
        out[i] = c < ncols ? __uint_as_float((unsigned)src[(size_t)row * pitch + c] << 16) : 0.f; }
}
#endif
extern "C" void kernel_launch(void* const* d_in, const int* in_sizes, int n_in, void* d_out, int out_size, void* d_ws, size_t ws_size, hipStream_t stream) {
    static int grid = 0;
    if (grid == 0) {
        if (n_in != 21 || out_size != MLAT * DM || ws_size < WS_END) { fprintf(stderr, "kernel_launch: unexpected shapes (n_in %d out %d ws %zu)\n", n_in, out_size, ws_size); grid = -1; return; }
        int dev = 0, cus = 0, per_cu = 0;
        hipGetDevice(&dev); hipDeviceGetAttribute(&cus, hipDeviceAttributeMultiprocessorCount, dev);
        if (hipFuncSetAttribute((const void*)mega, hipFuncAttributeMaxDynamicSharedMemorySize, LDS_BYTES) != hipSuccess) { fprintf(stderr, "kernel_launch: hipFuncSetAttribute failed\n"); grid = -1; return; }
        if (hipOccupancyMaxActiveBlocksPerMultiprocessor(&per_cu, (const void*)mega, NTHR, LDS_BYTES) != hipSuccess || per_cu < 1) { fprintf(stderr, "kernel_launch: occupancy query gave %d\n", per_cu); per_cu = 1; }
        (void)hipGetLastError();
        grid = cus * 1;
    }
    if (grid < 0) return;
    Params p{};
    for (int i = 0; i < 21; ++i) p.in[i] = (const float*)d_in[i];
    p.out = (float*)d_out; p.ws = (unsigned char*)d_ws;
#if MK_LAUNCHES == 1
    (void)hipMemsetAsync((unsigned char*)d_ws + WS_BAR, 0, XCD_BAR_WORDS * 4, stream);
    int lo = 0, hi = 12;
    void* args[] = {&p, &lo, &hi};
    hipError_t e = hipLaunchCooperativeKernel((const void*)mega, dim3(grid), dim3(NTHR), args, LDS_BYTES, stream);
    if (e != hipSuccess) fprintf(stderr, "cooperative launch failed: %s (grid %d)\n", hipGetErrorString(e), grid);
#else
#ifdef PROBE_K
    for (int ph = 0; ph <= PROBE_K; ++ph) hipLaunchKernelGGL(mega, dim3(grid), dim3(NTHR), LDS_BYTES, stream, p, ph, ph + 1);
    hipLaunchKernelGGL(dump_bf16, dim3(2048), dim3(256), 0, stream, (const bf16_t*)((unsigned char*)d_ws + PROBE_OFF), PROBE_PITCH, PROBE_NCOLS, (float*)d_out);
#else
    for (int ph = 0; ph < 12; ++ph) hipLaunchKernelGGL(mega, dim3(grid), dim3(NTHR), LDS_BYTES, stream, p, ph, ph + 1);
#endif
#endif
}
```

```cpp
#include <hip/hip_runtime.h>
#include <hip/hip_cooperative_groups.h>
#include <cstdio>
#include <cstdint>
namespace cg = cooperative_groups;

#ifndef MK_LAUNCHES
#define MK_LAUNCHES 1
#endif

#define LAS __attribute__((address_space(3)))
typedef unsigned short bf16_t;
typedef short bf16x8 __attribute__((ext_vector_type(8)));
typedef float f32x4 __attribute__((ext_vector_type(4)));
typedef unsigned u32x4 __attribute__((ext_vector_type(4)));
typedef unsigned u32x2 __attribute__((ext_vector_type(2)));
typedef LAS unsigned char* ldsp;

constexpr int NB = 8, SEQ = 2048, DM = 1024, CTXL = 256;
constexpr int MLAT = NB * SEQ;
constexpr int MCTX = NB * CTXL;
constexpr int MALL = MLAT + MCTX;
constexpr int INW = 2840, DFF = 2816;
constexpr int N1 = 3328;
constexpr float EPS = 1e-6f;
constexpr int NTHR = 512, NWAVE = 8;
constexpr int LDS_BYTES = 143360;

constexpr size_t MiB = 1u << 20;
constexpr size_t WS_BAR = 512 * 1024, WS_MOD = 0, WS_DT = 1 * MiB, WS_SSQG = 3 * MiB, WS_SSQ1 = 3 * MiB + 256 * 1024, WS_SSQ2 = 4 * MiB + 256 * 1024,
                 WS_AEND = 5 * MiB + 256 * 1024, WS_AENDC = WS_AEND + 16384,
                 WS_W1T = 6 * MiB, WS_WOT = WS_W1T + 6 * MiB + 512 * 1024, WS_WGUT = WS_WOT + 2 * MiB, WS_WDT = WS_WGUT + 11 * MiB,
                 WS_T = 31 * MiB, WS_VT = 47 * MiB, WS_Z = 63 * MiB, WS_H = 87 * MiB, WS_XBC = 123 * MiB, WS_ST = 186 * MiB, WS_STC = 234 * MiB,
                 WS_ACAT = WS_H, WS_O1 = 47 * MiB, WS_G = 123 * MiB, WS_END = 240 * MiB;

struct Params { const float* in[21]; float* out; unsigned char* ws; };

typedef float f32x2_t __attribute__((ext_vector_type(2)));
typedef __bf16 bf16x2_t __attribute__((ext_vector_type(2)));
__device__ __forceinline__ unsigned pk2(float lo, float hi) { const f32x2_t v = {lo, hi}; return __builtin_bit_cast(unsigned, __builtin_convertvector(v, bf16x2_t)); }
__device__ __forceinline__ float bflo(unsigned w) { return __uint_as_float(w << 16); }
__device__ __forceinline__ float bfhi(unsigned w) { return __uint_as_float(w & 0xffff0000u); }
__device__ __forceinline__ float silu_f(float x) { return x * __builtin_amdgcn_rcpf(1.0f + __expf(-x)); }
__device__ __forceinline__ float wave_sum(float v) {
#pragma unroll
    for (int o = 1; o < 64; o <<= 1) v += __shfl_xor(v, o);
    return v;
}
#define LDS_WAIT() asm volatile("s_waitcnt lgkmcnt(0)" ::: "memory")

namespace pg8 {
constexpr int BM = 256, BK = 64, HALF = 128, HTB = HALF * BK * 2, NXCD = 8, WGM = 8;
__device__ __forceinline__ int lds_byte(int r, int c) { const int st = (r >> 4) * 2 + (c >> 5), rr = r & 15, cc = c & 31, ob = rr * 64 + cc * 2; return st * 1024 + (ob ^ (((ob >> 9) & 1) << 5)); }
__device__ __forceinline__ void stage_rc(int b, int& R, int& C) { const int st = b / 1024, sb = b % 1024, swz = sb ^ (((sb >> 9) & 1) << 5); R = (st >> 1) * 16 + swz / 64; C = (st & 1) * 32 + (swz % 64) / 2; }
__device__ __forceinline__ int perm32(int rho) { const int n = rho >> 4, i = rho & 15; return 8 * (i >> 2) + 4 * n + (i & 3); }

struct Unit { int pm, pn, ko, sel, kt; };
struct Gemm { const bf16_t* A; const bf16_t* Bt; int lda, ldb, K; const bf16_t* A2; const bf16_t* Bt2; };

struct StaticOrder {
    int nM, nN, nwg, G, c;
    __device__ void init(int M, int N, int G_, int c_) { nM = M / BM; nN = N / BM; nwg = nM * nN; G = G_; c = c_; }
    __device__ bool next(int i, Unit& u) const {
        const long L = (long)i * G + c; if (L >= nwg) return false;
        int wgid = (int)L; { const int q = nwg / NXCD, r = nwg % NXCD, xcd = wgid % NXCD, off = wgid / NXCD; wgid = (xcd < r ? xcd * (q + 1) : r * (q + 1) + (xcd - r) * q) + off; }
        const int nig = WGM * nN, gid = wgid / nig, fm = gid * WGM, gsz = (nM - fm) < WGM ? (nM - fm) : WGM;
        u.pm = fm + ((wgid % nig) % gsz); u.pn = (wgid % nig) / gsz; u.ko = 0; u.sel = 0; u.kt = 0; return true;
    }
};
struct G1Order {
    StaticOrder so; int G, c;
    __device__ void init(int G_, int c_) { G = G_; c = c_; so.init(MALL, 2816, 1, 0); }
    __device__ bool next(int i, Unit& u) const {
        const int L = i * G + c; if (L >= 128 + 792) return false;
        if (L < 128) { u.pm = L & 1; u.pn = L >> 1; u.ko = 0; u.sel = 1; u.kt = 0; return true; }
        return so.next(L - 128, u);
    }
};
struct SplitKOrder {
    int G, c;
    __device__ bool next(int i, Unit& u) const {
        if (G != 256) { const int L = i * G + c; if (L >= 192) return false; const int tile = L / 3, ks = L % 3; u.pm = tile >> 3; u.pn = tile & 7; u.ko = ks * 1408; u.kt = ks < 2 ? 22 : 20; u.sel = 0; return true; }
        if (i > 0 || c < 64) return false;
        const int L = c - 64, tile = L / 3, ks = L % 3; u.pm = tile >> 3; u.pn = tile & 7; u.ko = ks * 1408; u.kt = ks < 2 ? 22 : 20; u.sel = 0; return true;
    }
};

template <class Epi, class Sched>
__device__ __forceinline__ void gemm_phase(ldsp lds, const Gemm g, const Sched& S, const Epi& E) {
    const int tid = threadIdx.x, wid = __builtin_amdgcn_readfirstlane(tid >> 6), lane = tid & 63, wr = wid >> 2, wc = wid & 3, fr = lane & 15, fq = lane >> 4;
    const int ntd = g.K / BK;
    unsigned voffA[2], voffB[2];
#pragma unroll
    for (int i = 0; i < 2; ++i) { int R, C; stage_rc(tid * 16 + i * 8192, R, C); const int Rb = Epi::PERM ? ((R & ~31) + perm32(R & 31)) : R;
        voffA[i] = (unsigned)(R * g.lda + C) * 2u; voffB[i] = (unsigned)(Rb * g.ldb + C) * 2u; }
    const size_t kstep = (size_t)(BK * 2);
    const size_t hstepA = (size_t)HALF * g.lda * 2, hstepB = (size_t)HALF * g.ldb * 2, tstepA = 2 * hstepA, tstepB = 2 * hstepB;
    const unsigned ldsw = (unsigned)wid * 1024u;
    const int aoff = lds_byte(wr * 64 + fr, fq * 8), boff = lds_byte(wc * 32 + fr, fq * 8);
#define PG8_SA(b, h) (((b) * 2 + (h)) * HTB)
#define PG8_SB(b, h) ((4 + (b) * 2 + (h)) * HTB)
#define PG8_STAGE(bufoff, gbase, voff) do { _Pragma("unroll") for (int _i = 0; _i < 2; ++_i) \
        __builtin_amdgcn_global_load_lds((const unsigned*)((const char*)(gbase) + (voff)[_i]), (LAS unsigned*)(lds + (bufoff) + ldsw + _i * 8192), 16, 0, 0); } while (0)
#define PG8_LDA(dst, b, h) do { _Pragma("unroll") for (int m = 0; m < 4; ++m) _Pragma("unroll") for (int k = 0; k < 2; ++k) dst[m][k] = *(const LAS bf16x8*)(lds + PG8_SA(b, h) + aoff + m * 2048 + k * 1024); } while (0)
#define PG8_LDB(dst, b, h) do { _Pragma("unroll") for (int n = 0; n < 2; ++n) _Pragma("unroll") for (int k = 0; k < 2; ++k) dst[n][k] = *(const LAS bf16x8*)(lds + PG8_SB(b, h) + boff + n * 2048 + k * 1024); } while (0)
#define PG8_MMA(ai, bj, At, Bt) do { __builtin_amdgcn_s_setprio(1); _Pragma("unroll") for (int m = 0; m < 4; ++m) _Pragma("unroll") for (int n = 0; n < 2; ++n) _Pragma("unroll") for (int k = 0; k < 2; ++k) \
        acc[ai][bj][m][n] = __builtin_amdgcn_mfma_f32_16x16x32_bf16(Bt[n][k], At[m][k], acc[ai][bj][m][n], 0, 0, 0); __builtin_amdgcn_s_setprio(0); } while (0)
#define PG8_WAIT_V(n) asm volatile("s_waitcnt vmcnt(" #n ")" ::: "memory")
#define PG8_WAIT_L(n) asm volatile("s_waitcnt lgkmcnt(" #n ")" ::: "memory")
#define PG8_BAR __builtin_amdgcn_s_barrier()
#define PG8_SCHED __builtin_amdgcn_sched_barrier(0)
    Unit cur, nxt; int ui = 0;
    if (!S.next(0, cur)) return;
    f32x4 acc[2][2][4][2];
#pragma unroll
    for (int a = 0; a < 2; ++a)
#pragma unroll
        for (int b = 0; b < 2; ++b)
#pragma unroll
            for (int m = 0; m < 4; ++m)
#pragma unroll
                for (int n = 0; n < 2; ++n) acc[a][b][m][n] = (f32x4){0.f, 0.f, 0.f, 0.f};
    bf16x8 At[4][2], B0[2][2], B1[2][2];
    const char* cA = (const char*)(cur.sel ? g.A2 : g.A) + (size_t)cur.pm * tstepA + (size_t)cur.ko * 2; const char* cB = (const char*)(cur.sel ? g.Bt2 : g.Bt) + (size_t)cur.pn * tstepB + (size_t)cur.ko * 2;
    PG8_STAGE(PG8_SB(0, 0), cB, voffB); PG8_STAGE(PG8_SB(0, 1), cB + hstepB, voffB); PG8_STAGE(PG8_SA(0, 0), cA, voffA); PG8_STAGE(PG8_SA(0, 1), cA + hstepA, voffA);
    if (wr == 1) PG8_BAR;
    PG8_WAIT_V(2); PG8_BAR;
    PG8_STAGE(PG8_SB(1, 0), cB + kstep, voffB); PG8_STAGE(PG8_SA(1, 0), cA + kstep, voffA); PG8_STAGE(PG8_SB(1, 1), cB + hstepB + kstep, voffB);
    PG8_WAIT_V(6); PG8_BAR;
    for (;;) {
        const bool has_next = S.next(ui + 1, nxt);
        const char* nA = has_next ? (const char*)(nxt.sel ? g.A2 : g.A) + (size_t)nxt.pm * tstepA + (size_t)nxt.ko * 2 : cA; const char* nB = has_next ? (const char*)(nxt.sel ? g.Bt2 : g.Bt) + (size_t)nxt.pn * tstepB + (size_t)nxt.ko * 2 : cB;
        const int nt = cur.kt ? cur.kt : ntd;
        for (int t = 0; t < nt; t += 2) {
            if constexpr (Epi::HOOK) { if (t == Epi::HOOK_T) E.hook(acc, cur, wr, fr); }
            const bool last = (t == nt - 2);
            const char* a1 = cA + (size_t)(t + 1) * kstep;
            const char* a2 = last ? nA : cA + (size_t)(t + 2) * kstep; const char* b2 = last ? nB : cB + (size_t)(t + 2) * kstep;
            const char* a3 = a2 + kstep; const char* b3 = b2 + kstep;
            PG8_LDB(B0, 0, 0); PG8_LDB(B1, 0, 1); PG8_SCHED; PG8_LDA(At, 0, 0); PG8_STAGE(PG8_SA(1, 1), a1 + hstepA, voffA);
            PG8_WAIT_V(8); PG8_WAIT_L(0); PG8_BAR; PG8_MMA(0, 0, At, B0); PG8_MMA(0, 1, At, B1); PG8_BAR; PG8_SCHED;
            PG8_LDA(At, 0, 1); PG8_STAGE(PG8_SB(0, 0), b2, voffB); PG8_STAGE(PG8_SB(0, 1), b2 + hstepB, voffB); PG8_STAGE(PG8_SA(0, 0), a2, voffA);
            PG8_WAIT_V(8); PG8_WAIT_L(0); PG8_BAR; PG8_MMA(1, 0, At, B0); PG8_MMA(1, 1, At, B1); PG8_BAR; PG8_SCHED;
            PG8_LDB(B0, 1, 0); PG8_LDB(B1, 1, 1); PG8_SCHED; PG8_LDA(At, 1, 0); PG8_STAGE(PG8_SA(0, 1), a2 + hstepA, voffA);
            PG8_WAIT_V(8); PG8_WAIT_L(0); PG8_BAR; PG8_MMA(0, 0, At, B0); PG8_MMA(0, 1, At, B1); PG8_BAR; PG8_SCHED;
            PG8_LDA(At, 1, 1); PG8_STAGE(PG8_SB(1, 0), b3, voffB); PG8_STAGE(PG8_SB(1, 1), b3 + hstepB, voffB); PG8_STAGE(PG8_SA(1, 0), a3, voffA);
            PG8_WAIT_V(8); PG8_WAIT_L(0); PG8_BAR; PG8_MMA(1, 0, At, B0); PG8_MMA(1, 1, At, B1); PG8_BAR; PG8_SCHED;
        }
        if (wr == 0) PG8_BAR;
        E(acc, cur, wr, wc, fr, fq);
        if (!has_next) break;
#pragma unroll
        for (int a = 0; a < 2; ++a)
#pragma unroll
            for (int b = 0; b < 2; ++b)
#pragma unroll
                for (int m = 0; m < 4; ++m)
#pragma unroll
                    for (int n = 0; n < 2; ++n) acc[a][b][m][n] = (f32x4){0.f, 0.f, 0.f, 0.f};
        cur = nxt; cA = nA; cB = nB; ++ui;
        if (wr == 1) PG8_BAR;
    }
    PG8_WAIT_V(0);
    PG8_BAR;
    asm volatile("" ::: "memory");
    __syncthreads();
#undef PG8_SA
#undef PG8_SB
#undef PG8_STAGE
#undef PG8_LDA
#undef PG8_LDB
#undef PG8_MMA
#undef PG8_WAIT_V
#undef PG8_WAIT_L
#undef PG8_BAR
#undef PG8_SCHED
}

struct Epi1 {
    static constexpr bool PERM = true, HOOK = false; static constexpr int HOOK_T = -1;
    bf16_t* VT; bf16_t* Z; bf16_t* XR; float* DT;
    __device__ __forceinline__ void hook(f32x4 (&)[2][2][4][2], const Unit&, int, int) const {}
    __device__ __forceinline__ void operator()(const f32x4 (&acc)[2][2][4][2], const Unit& u, int wr, int wc, int fr, int fq) const {
        const int pn = u.pn, pm = u.pm;
        if (u.sel) {
            const int b = pn >> 3, t0 = (pn & 7) * 256 + 32 * wc + 8 * fq;
#pragma unroll
            for (int ai = 0; ai < 2; ++ai)
#pragma unroll
                for (int m = 0; m < 4; ++m) { const int cc = ai * 128 + wr * 64 + m * 16 + fr; bf16_t* rowp = VT + (size_t)(b * 256 + cc) * 4096 + pm * 2048 + t0;
#pragma unroll
                    for (int bj = 0; bj < 2; ++bj) { const f32x4 v0 = acc[ai][bj][m][0], v1 = acc[ai][bj][m][1];
                        u32x4 w; w.x = pk2(v0[0], v0[1]); w.y = pk2(v0[2], v0[3]); w.z = pk2(v1[0], v1[1]); w.w = pk2(v1[2], v1[3]);
                        *(u32x4*)(rowp + 128 * bj) = w; } }
        } else if (pn < 10) {
            bf16_t* base; int ld, c0;
            if (pn < 3) { if (pm >= 64) return; base = Z; ld = 768; c0 = 256 * pn; } else { base = XR; ld = 1792; c0 = 256 * (pn - 3); }
#pragma unroll
            for (int ai = 0; ai < 2; ++ai)
#pragma unroll
                for (int m = 0; m < 4; ++m) { const int row = pm * 256 + ai * 128 + wr * 64 + m * 16 + fr;
#pragma unroll
                    for (int bj = 0; bj < 2; ++bj) { const f32x4 v0 = acc[ai][bj][m][0], v1 = acc[ai][bj][m][1];
                        u32x4 w; w.x = pk2(v0[0], v0[1]); w.y = pk2(v0[2], v0[3]); w.z = pk2(v1[0], v1[1]); w.w = pk2(v1[2], v1[3]);
                        *(u32x4*)(base + (size_t)row * ld + c0 + 128 * bj + 32 * wc + 8 * fq) = w; } }
        } else {
            if (wc == 0 && fq < 3) {
#pragma unroll
                for (int ai = 0; ai < 2; ++ai)
#pragma unroll
                    for (int m = 0; m < 4; ++m) { const int row = pm * 256 + ai * 128 + wr * 64 + m * 16 + fr;
#pragma unroll
                        for (int n = 0; n < 2; ++n) *(f32x4*)(DT + (size_t)row * 24 + 8 * fq + 4 * n) = acc[ai][0][m][n]; }
            }
        }
    }
};
struct EpiFP {
    static constexpr bool PERM = false, HOOK = false; static constexpr int HOOK_T = -1;
    float* FP;
    __device__ __forceinline__ void hook(f32x4 (&)[2][2][4][2], const Unit&, int, int) const {}
    __device__ __forceinline__ void operator()(const f32x4 (&acc)[2][2][4][2], const Unit& u, int wr, int wc, int fr, int fq) const {
        float* base = FP + (size_t)(u.ko / 1408) * 2048 * 2048;
#pragma unroll
        for (int ai = 0; ai < 2; ++ai)
#pragma unroll
            for (int m = 0; m < 4; ++m) { float* rowp = base + (size_t)(u.pm * 256 + ai * 128 + wr * 64 + m * 16 + fr) * 2048 + u.pn * 256 + wc * 32 + 4 * fq;
#pragma unroll
                for (int bj = 0; bj < 2; ++bj)
#pragma unroll
                    for (int n = 0; n < 2; ++n) *(f32x4*)(rowp + bj * 128 + n * 16) = acc[ai][bj][m][n]; }
    }
};
template <bool HK> struct EpiNorm {
    static constexpr bool PERM = true, HOOK = HK; static constexpr int HOOK_T = 12;
    bf16_t* O; float* SSQ; const float* SSQG;
    __device__ __forceinline__ void hook(f32x4 (&acc)[2][2][4][2], const Unit& u, int wr, int fr) const {
        int rbase = u.pm * 256 + wr * 64 + fr;
        asm volatile("" : "+v"(rbase));
#pragma unroll
        for (int ai = 0; ai < 2; ++ai)
#pragma unroll
            for (int m = 0; m < 4; ++m) { const int row = rbase + ai * 128 + m * 16;
                const f32x4 s = *(const f32x4*)(SSQG + (size_t)row * 4); const float rs = rsqrtf(((s[0] + s[1]) + (s[2] + s[3])) * (1.0f / 768.0f) + EPS);
#pragma unroll
                for (int bj = 0; bj < 2; ++bj)
#pragma unroll
                    for (int n = 0; n < 2; ++n) acc[ai][bj][m][n] *= rs;
                asm volatile("" ::: "memory"); }
    }
    __device__ __forceinline__ void operator()(const f32x4 (&acc)[2][2][4][2], const Unit& u, int wr, int wc, int fr, int fq) const {
#pragma unroll
        for (int ai = 0; ai < 2; ++ai)
#pragma unroll
            for (int m = 0; m < 4; ++m) { const int row = u.pm * 256 + ai * 128 + wr * 64 + m * 16 + fr; float s = 0.f;
#pragma unroll
                for (int bj = 0; bj < 2; ++bj) { const f32x4 v0 = acc[ai][bj][m][0], v1 = acc[ai][bj][m][1];
                    s += (v0[0] * v0[0] + v0[1] * v0[1]) + (v0[2] * v0[2] + v0[3] * v0[3]) + (v1[0] * v1[0] + v1[1] * v1[1]) + (v1[2] * v1[2] + v1[3] * v1[3]);
                    u32x4 w; w.x = pk2(v0[0], v0[1]); w.y = pk2(v0[2], v0[3]); w.z = pk2(v1[0], v1[1]); w.w = pk2(v1[2], v1[3]);
                    *(u32x4*)(O + (size_t)row * 1024 + u.pn * 256 + 128 * bj + 32 * wc + 8 * fq) = w; }
                s += __shfl_xor(s, 16); s += __shfl_xor(s, 32);
                if (fq == 0) SSQ[(size_t)row * 16 + u.pn * 4 + wc] = s; }
    }
};
struct EpiSwiglu {
    static constexpr bool PERM = true, HOOK = false; static constexpr int HOOK_T = -1;
    bf16_t* Gb;
    __device__ __forceinline__ void hook(f32x4 (&)[2][2][4][2], const Unit&, int, int) const {}
    __device__ __forceinline__ void operator()(const f32x4 (&acc)[2][2][4][2], const Unit& u, int wr, int wc, int fr, int fq) const {
#pragma unroll
        for (int ai = 0; ai < 2; ++ai)
#pragma unroll
            for (int m = 0; m < 4; ++m) { const int row = u.pm * 256 + ai * 128 + wr * 64 + m * 16 + fr;
                float h[8];
#pragma unroll
                for (int n = 0; n < 2; ++n)
#pragma unroll
                    for (int j = 0; j < 4; ++j) h[n * 4 + j] = silu_f(acc[ai][0][m][n][j]) * acc[ai][1][m][n][j];
                u32x4 w; w.x = pk2(h[0], h[1]); w.y = pk2(h[2], h[3]); w.z = pk2(h[4], h[5]); w.w = pk2(h[6], h[7]);
                *(u32x4*)(Gb + (size_t)row * DFF + u.pn * 128 + 32 * wc + 8 * fq) = w; }
    }
};
}

__device__ __forceinline__ void p0_gemv(const Params& P, ldsp lds, int unit) {
    LAS float* s = (LAS float*)lds; LAS float* red = s + 9 * 1024;
    const int tid = threadIdx.x;
    const float* c = P.in[1]; const float* cctx = P.in[3]; const float* w_ada = P.in[4]; const float* b_ada = P.in[5];
    float* mod = (float*)(P.ws + WS_MOD);
    const int cgi = tid % 24, kg = tid / 24, col = unit * 24 + cgi;
    float w[64];
    if (kg < 16) {
#pragma unroll
        for (int kk = 0; kk < 64; ++kk) w[kk] = w_ada[(size_t)(kg * 64 + kk) * 6144 + col];
    }
    for (int i = tid; i < 9 * 1024; i += NTHR) { const int r = i >> 10, k = i & 1023; const float v = (r < 8) ? c[r * 1024 + k] : cctx[k]; s[i] = v / (1.0f + __expf(-v)); }
    __syncthreads();
    if (kg < 16) {
        float acc[9];
#pragma unroll
        for (int r = 0; r < 9; ++r) acc[r] = 0.f;
#pragma unroll
        for (int k4 = 0; k4 < 16; ++k4)
#pragma unroll
            for (int r = 0; r < 9; ++r) { const f32x4 s4 = *(const LAS f32x4*)(s + r * 1024 + kg * 64 + k4 * 4);
                acc[r] += s4[0] * w[k4 * 4] + s4[1] * w[k4 * 4 + 1] + s4[2] * w[k4 * 4 + 2] + s4[3] * w[k4 * 4 + 3]; }
#pragma unroll
        for (int r = 0; r < 9; ++r) red[(kg * 9 + r) * 24 + cgi] = acc[r];
    }
    __syncthreads();
    if (tid < 216) { const int r = tid / 24, c2 = tid % 24; float sum = 0.f;
#pragma unroll
        for (int q = 0; q < 16; ++q) sum += red[(q * 9 + r) * 24 + c2];
        mod[r * 6144 + unit * 24 + c2] = sum + b_ada[unit * 24 + c2]; }
    __syncthreads();
}
__device__ __forceinline__ void tr_item(const float* src, int spitch, int ks0, int c0, int nvalid, bf16_t* dst, int dpitch, int n0, int k0, const float* kscale, LAS float* scr, int lane) {
    float tv[32];
#pragma unroll
    for (int i = 0; i < 32; ++i) { const int kk = 2 * i + (lane >> 5), n = lane & 31; tv[i] = 0.f;
        if (n < nvalid) tv[i] = src[(size_t)(ks0 + kk) * spitch + c0 + n]; }
#pragma unroll
    for (int i = 0; i < 32; ++i) { const int kk = 2 * i + (lane >> 5), n = lane & 31; float v = tv[i];
        if (kscale) v *= kscale[kk];
        scr[kk * 33 + n] = v; }
    LDS_WAIT();
    const int c = lane & 7;
#pragma unroll
    for (int j = 0; j < 4; ++j) { const int n = (lane >> 3) + 8 * j; const LAS float* s = scr + (8 * c) * 33 + n;
        u32x4 o; o.x = pk2(s[0 * 33], s[1 * 33]); o.y = pk2(s[2 * 33], s[3 * 33]); o.z = pk2(s[4 * 33], s[5 * 33]); o.w = pk2(s[6 * 33], s[7 * 33]);
        *(u32x4*)(dst + (size_t)(n0 + n) * dpitch + k0 + 8 * c) = o; }
    LDS_WAIT();
}
__device__ __forceinline__ void p0_prep(const Params& P, ldsp lds) {
    const int tid = threadIdx.x, lane = tid & 63, wave = tid >> 6, G = gridDim.x;
    for (int u = blockIdx.x; u < 256; u += G) p0_gemv(P, lds, u);
    LAS float* tab = (LAS float*)lds;
    LAS float* tab64 = (LAS float*)(lds + 8192 + 8 * 8448);
    for (int i = tid; i < 2048; i += NTHR) tab[i] = cospif((float)i * (1.0f / 1024.0f));
    if (tid < 64) tab64[tid] = cospif((float)tid * (1.0f / 32.0f));
    __syncthreads();
    LAS float* scr = (LAS float*)(lds + 8192 + wave * 8448);
    const float* w_in = P.in[10]; const float* g_ssd = P.in[16]; const float* w_out = P.in[17]; const float* w_gate = P.in[18]; const float* w_up = P.in[19]; const float* w_down = P.in[20];
    bf16_t* W1T = (bf16_t*)(P.ws + WS_W1T); bf16_t* WOT = (bf16_t*)(P.ws + WS_WOT); bf16_t* WGUT = (bf16_t*)(P.ws + WS_WGUT); bf16_t* WDT = (bf16_t*)(P.ws + WS_WDT);
    const int gw = wave * G + blockIdx.x, NGW = G * NWAVE;
    constexpr int I_A = 88 * 16, I_B = 32 * 16, I_C = 176 * 16, I_D = 32 * 44, I_E = 512;
    for (int it = gw; it < I_A + I_B + I_C + I_D + I_E; it += NGW) {
        int r = it;
        if (r < I_E) {
            const int kb = r & 15, g = (r >> 4) & 3, cs = (r >> 6) & 1, qt = r >> 7, k = kb * 64 + lane;
            float a[16];
#pragma unroll
            for (int kp = 0; kp < 16; ++kp) a[kp] = 0.f;
#pragma unroll 2
            for (int jc = 0; jc < 8; ++jc) { const f32x4 t0 = *(const f32x4*)(w_in + (size_t)k * INW + g * 64 + jc * 8), t1 = *(const f32x4*)(w_in + (size_t)k * INW + g * 64 + jc * 8 + 4);
                const float v[8] = {t0[0], t0[1], t0[2], t0[3], t1[0], t1[1], t1[2], t1[3]};
#pragma unroll
                for (int kp = 0; kp < 16; ++kp) { const int k2 = qt * 16 + kp;
#pragma unroll
                    for (int jj = 0; jj < 8; ++jj) a[kp] += v[jj] * tab64[((jc * 8 + jj) * k2 - 16 * cs) & 63]; } }
#pragma unroll
            for (int kp = 0; kp < 16; ++kp) W1T[(size_t)(cs * 256 + g * 64 + qt * 16 + kp) * 1024 + k] = (bf16_t)(pk2(a[kp] * 0.125f, 0.f) & 0xffffu);
            continue; }
        r -= I_E;
        if (r < I_A) { const int nb = 16 + r / 16, kb = r % 16, n0 = nb * 32; int c0 = 0, nv = 32;
            if (n0 < 1280) c0 = 256 + (n0 - 512); else if (n0 < 3072) c0 = 1024 + (n0 - 1280); else if (n0 == 3072) { c0 = 2816; nv = 24; } else nv = 0;
            tr_item(w_in, INW, kb * 64, c0, nv, W1T, 1024, n0, kb * 64, nullptr, scr, lane); continue; }
        r -= I_A;
        if (r < I_B) { const int nb = r / 16, kb = r % 16, k0 = kb * 64;
            if (k0 < 768) tr_item(w_out, 1024, 256 + k0, nb * 32, 32, WOT, 1024, nb * 32, k0, g_ssd + k0, scr, lane);
            else tr_item(w_out, 1024, k0 - 768, nb * 32, 32, WOT, 1024, nb * 32, k0, nullptr, scr, lane);
            continue; }
        r -= I_B;
        if (r < I_C) { const int nb = r / 16, kb = r % 16, n0 = nb * 32, pn = n0 >> 8, bj = (n0 >> 7) & 1, i0 = n0 & 127;
            tr_item(bj ? w_up : w_gate, DFF, kb * 64, 128 * pn + i0, 32, WGUT, 1024, n0, kb * 64, nullptr, scr, lane); continue; }
        r -= I_C;
        { const int nb = r / 44, kb = r % 44; tr_item(w_down, 1024, kb * 64, nb * 32, 32, WDT, DFF, nb * 32, kb * 64, nullptr, scr, lane); }
    }
    bf16_t* T = (bf16_t*)(P.ws + WS_T);
    for (int it = blockIdx.x * NTHR + tid; it < 2048 * 512; it += G * NTHR) {
        const int tp = it >> 9, kk0 = (it & 511) * 8, cs = kk0 >> 11, t0 = kk0 & 2047; float v[8];
#pragma unroll
        for (int e = 0; e < 8; ++e) { const int idx = ((t0 + e) * tp) & 2047; v[e] = (cs ? -tab[(idx - 512) & 2047] : tab[idx]) * 0.02209708691f; }
        u32x4 o; o.x = pk2(v[0], v[1]); o.y = pk2(v[2], v[3]); o.z = pk2(v[4], v[5]); o.w = pk2(v[6], v[7]);
        *(u32x4*)(T + (size_t)tp * 4096 + kk0) = o; }
}

__device__ __forceinline__ void p1_norm(const Params& P) {
    const int tid = threadIdx.x, lane = tid & 63, wave = tid >> 6, G = gridDim.x;
    const int gw = blockIdx.x * NWAVE + wave, NGW = G * NWAVE;
    const float* x = P.in[0]; const float* ctx = P.in[2]; const float* gpre = P.in[6]; const float* mod = (const float*)(P.ws + WS_MOD);
    bf16_t* H = (bf16_t*)(P.ws + WS_H);
    constexpr int R = 3;
    int curb = -1; f32x4 a[4], sft[4];
    const int UPW = (MALL / R + NGW - 1) / NGW;
    for (int i = 0; i < UPW; ++i) { const int u = gw * UPW + i; if (u >= MALL / R) break; const int row0 = u * R;
        f32x4 v[R][4];
#pragma unroll
        for (int r = 0; r < R; ++r) { const int row = row0 + r; const float* src = row < MLAT ? x + (size_t)row * DM : ctx + (size_t)(row - MLAT) * DM;
#pragma unroll
            for (int j = 0; j < 4; ++j) v[r][j] = *(const f32x4*)(src + 4 * lane + 256 * j); }
#pragma unroll
        for (int r = 0; r < R; ++r) { const int row = row0 + r; const int mb = row < MLAT ? (row >> 11) : 8;
            if (mb != curb) { curb = mb;
#pragma unroll
                for (int j = 0; j < 4; ++j) { const int k = 4 * lane + 256 * j; const f32x4 gg = *(const f32x4*)(gpre + k), sc = *(const f32x4*)(mod + mb * 6144 + 1024 + k);
                    a[j] = gg * (sc + 1.0f); sft[j] = *(const f32x4*)(mod + mb * 6144 + k); } }
            float ss = 0.f;
#pragma unroll
            for (int j = 0; j < 4; ++j) ss += (v[r][j][0] * v[r][j][0] + v[r][j][1] * v[r][j][1]) + (v[r][j][2] * v[r][j][2] + v[r][j][3] * v[r][j][3]);
            const float rstd = rsqrtf(wave_sum(ss) * (1.0f / DM) + EPS);
#pragma unroll
            for (int j = 0; j < 4; ++j) { const f32x4 h = v[r][j] * rstd * a[j] + sft[j]; u32x2 w; w.x = pk2(h[0], h[1]); w.y = pk2(h[2], h[3]);
                *(u32x2*)(H + (size_t)row * DM + 4 * lane + 256 * j) = w; } }
    }
}

__device__ __forceinline__ void p3_conv(const Params& P) {
    const int G = gridDim.x;
    const bf16_t* XR = (const bf16_t*)P.out; bf16_t* XBC = (bf16_t*)(P.ws + WS_XBC);
    const float* conv_w = P.in[11]; const float* conv_b = P.in[12];
    for (int it = blockIdx.x * NTHR + threadIdx.x; it < 576 * 224; it += G * NTHR) {
        const int cg8 = it % 224, seg = it / 224, c0 = cg8 * 8, r0 = seg * 32;
        int rs, re; if (r0 < MLAT) { rs = r0 & ~63; re = rs + 64; } else { rs = MLAT + ((r0 - MLAT) & ~255); re = rs + 256; }
        float w[8][7], bias[8];
#pragma unroll
        for (int c = 0; c < 8; ++c) { bias[c] = conv_b[c0 + c];
#pragma unroll
            for (int k = 0; k < 7; ++k) w[c][k] = conv_w[(c0 + c) * 7 + k]; }
        float win[7][8];
#pragma unroll
        for (int k = 0; k < 7; ++k)
#pragma unroll
            for (int c = 0; c < 8; ++c) win[k][c] = 0.f;
#pragma unroll
        for (int half = 0; half < 2; ++half) { constexpr int NL0 = 22, NL1 = 16; const int i0 = half ? NL0 : 0;
            u32x4 raw[NL0];
#pragma unroll
            for (int ii = 0; ii < NL0; ++ii) { raw[ii] = (u32x4){0u, 0u, 0u, 0u}; if (ii < (half ? NL1 : NL0)) { const int src = r0 - 3 + i0 + ii; if (src >= rs && src < re) raw[ii] = *(const u32x4*)(XR + (size_t)src * 1792 + c0); } }
#pragma unroll
            for (int ii = 0; ii < NL0; ++ii) { if (ii < (half ? NL1 : NL0)) { const int i = i0 + ii;
#pragma unroll
                for (int k = 0; k < 6; ++k)
#pragma unroll
                    for (int c = 0; c < 8; ++c) win[k][c] = win[k + 1][c];
                win[6][0] = bflo(raw[ii].x); win[6][1] = bfhi(raw[ii].x); win[6][2] = bflo(raw[ii].y); win[6][3] = bfhi(raw[ii].y); win[6][4] = bflo(raw[ii].z); win[6][5] = bfhi(raw[ii].z); win[6][6] = bflo(raw[ii].w); win[6][7] = bfhi(raw[ii].w);
                if (i >= 6) { float o[8];
#pragma unroll
                    for (int c = 0; c < 8; ++c) { float acc = bias[c];
#pragma unroll
                        for (int k = 0; k < 7; ++k) acc += w[c][k] * win[k][c];
                        o[c] = silu_f(acc); }
                    u32x4 ov; ov.x = pk2(o[0], o[1]); ov.y = pk2(o[2], o[3]); ov.z = pk2(o[4], o[5]); ov.w = pk2(o[6], o[7]);
                    *(u32x4*)(XBC + (size_t)(r0 + i - 6) * 1792 + c0) = ov; } } } }
    }
}

__device__ __forceinline__ float softplus_f(float x) { return x > 20.f ? x : log1pf(expf(x)); }
__device__ __forceinline__ void chunk_scan(const float* DT, size_t rowbase, int col, float bias, float negA, int lane,
                                           float& dt0, float& dt1, float& pi0, float& pi1, float& pe0, float& pe1, float& total) {
    const float r0 = DT[(rowbase + 2 * lane) * 24 + col], r1 = DT[(rowbase + 2 * lane + 1) * 24 + col];
    dt0 = softplus_f(r0 + bias); dt1 = softplus_f(r1 + bias);
    const float a0 = dt0 * negA, a1 = dt1 * negA; float p = a0 + a1;
#pragma unroll
    for (int o = 1; o < 64; o <<= 1) { const float v = __shfl_up(p, o); if (lane >= o) p += v; }
    total = __shfl(p, 63);
    pi1 = p; pi0 = p - a1; pe1 = pi0; pe0 = pi0 - a0;
}
__device__ __forceinline__ void load_transposed(const bf16_t* src, int nch8, LAS bf16_t* dst, int tid) {
    const int nitem = nch8 * 64;
    for (int idx = tid; idx < nitem; idx += NTHR) { const int q = idx >> 5, s2 = (idx & 31) + 32 * (q & 1), ch8 = q >> 1;
        const u32x4 lo = *(const u32x4*)(src + (size_t)(2 * s2) * 1792 + ch8 * 8), hi = *(const u32x4*)(src + (size_t)(2 * s2 + 1) * 1792 + ch8 * 8);
        LAS unsigned* d = (LAS unsigned*)(dst + (ch8 * 8) * 136 + 2 * s2);
        d[0 * 68] = (lo.x & 0xffffu) | (hi.x << 16); d[1 * 68] = (lo.x >> 16) | (hi.x & 0xffff0000u);
        d[2 * 68] = (lo.y & 0xffffu) | (hi.y << 16); d[3 * 68] = (lo.y >> 16) | (hi.y & 0xffff0000u);
        d[4 * 68] = (lo.z & 0xffffu) | (hi.z << 16); d[5 * 68] = (lo.z >> 16) | (hi.z & 0xffff0000u);
        d[6 * 68] = (lo.w & 0xffffu) | (hi.w << 16); d[7 * 68] = (lo.w >> 16) | (hi.w & 0xffff0000u); }
}
__device__ __forceinline__ bf16x8 scale8(bf16x8 x, f32x4 w0, f32x4 w1) {
    const u32x4 u = __builtin_bit_cast(u32x4, x); u32x4 o;
    o.x = pk2(bflo(u.x) * w0[0], bfhi(u.x) * w0[1]); o.y = pk2(bflo(u.y) * w0[2], bfhi(u.y) * w0[3]);
    o.z = pk2(bflo(u.z) * w1[0], bfhi(u.z) * w1[1]); o.w = pk2(bflo(u.w) * w1[2], bfhi(u.w) * w1[3]);
    return __builtin_bit_cast(bf16x8, o);
}

__device__ __forceinline__ void ssd_states_unit(const Params& P, ldsp lds, int u) {
    const int tid = threadIdx.x, lane = tid & 63, wave = __builtin_amdgcn_readfirstlane(tid >> 6), fr = lane & 15, fq = lane >> 4;
    int b, c, g; size_t rowbase; bf16_t* STb; float* AE;
    if (u < 512) { b = u >> 6; c = (u >> 2) & 15; g = u & 3; rowbase = (size_t)b * SEQ + c * 128;
        STb = (bf16_t*)(P.ws + WS_ST) + (size_t)(b * 16 + c) * 24 * 8192; AE = (float*)(P.ws + WS_AEND) + (b * 16 + c) * 24; }
    else { const int v = u - 512; b = v >> 3; c = (v >> 2) & 1; g = v & 3; rowbase = (size_t)MLAT + b * CTXL + c * 128;
        STb = (bf16_t*)(P.ws + WS_STC) + (size_t)(b * 2 + c) * 24 * 8192; AE = (float*)(P.ws + WS_AENDC) + (b * 2 + c) * 24; }
    const bf16_t* XBC = (const bf16_t*)(P.ws + WS_XBC); const float* DT = (const float*)(P.ws + WS_DT);
    LAS bf16_t* BT = (LAS bf16_t*)lds; LAS bf16_t* XT = (LAS bf16_t*)(lds + 34816); LAS float* wl = (LAS float*)(lds + 87040);
    if (wave < 6) { const int r = wave % 3, dir = wave / 3, hd = dir * 12 + g * 3 + r;
        float dt0, dt1, pi0, pi1, pe0, pe1, tot;
        chunk_scan(DT, rowbase, hd, P.in[13][hd], -expf(P.in[14][hd]), lane, dt0, dt1, pi0, pi1, pe0, pe1, tot);
        float w0, w1; if (dir == 0) { w0 = dt0 * __expf(tot - pi0); w1 = dt1 * __expf(tot - pi1); } else { w0 = dt0 * __expf(pe0); w1 = dt1 * __expf(pe1); }
        wl[wave * 128 + 2 * lane] = w0; wl[wave * 128 + 2 * lane + 1] = w1;
        if (lane == 0) AE[hd] = tot; }
    load_transposed(XBC + rowbase * 1792 + 768 + g * 128, 16, BT, tid);
    load_transposed(XBC + rowbase * 1792 + g * 192, 24, XT, tid);
    __syncthreads();
    bf16x8 bfr[4];
#pragma unroll
    for (int kk = 0; kk < 4; ++kk) bfr[kk] = *(const LAS bf16x8*)(BT + (16 * wave + fr) * 136 + kk * 32 + fq * 8);
#pragma unroll 1
    for (int combo = 0; combo < 6; ++combo) { const int r = combo % 3, dir = combo / 3;
        f32x4 acc[4];
#pragma unroll
        for (int mb = 0; mb < 4; ++mb) acc[mb] = (f32x4){0.f, 0.f, 0.f, 0.f};
#pragma unroll
        for (int kk = 0; kk < 4; ++kk) { const f32x4 w0 = *(const LAS f32x4*)(wl + combo * 128 + kk * 32 + fq * 8), w1 = *(const LAS f32x4*)(wl + combo * 128 + kk * 32 + fq * 8 + 4);
#pragma unroll
            for (int mb = 0; mb < 4; ++mb) { const bf16x8 xr = *(const LAS bf16x8*)(XT + (r * 64 + mb * 16 + fr) * 136 + kk * 32 + fq * 8);
                acc[mb] = __builtin_amdgcn_mfma_f32_16x16x32_bf16(bfr[kk], scale8(xr, w0, w1), acc[mb], 0, 0, 0); } }
        bf16_t* dst = STb + (size_t)(dir * 12 + g * 3 + r) * 8192;
#pragma unroll
        for (int mb = 0; mb < 4; ++mb) { u32x2 w; w.x = pk2(acc[mb][0], acc[mb][1]); w.y = pk2(acc[mb][2], acc[mb][3]);
            *(u32x2*)(dst + (mb * 16 + fr) * 128 + 16 * wave + 4 * fq) = w; } }
    __syncthreads();
}

__device__ __forceinline__ void p5_scan(const Params& P) {
    const int G = gridDim.x;
    bf16_t* ST = (bf16_t*)(P.ws + WS_ST); const bf16_t* STC = (const bf16_t*)(P.ws + WS_STC);
    const float* AE = (const float*)(P.ws + WS_AEND); const float* AEC = (const float*)(P.ws + WS_AENDC);
    for (int it = blockIdx.x * NTHR + threadIdx.x; it < NB * 24 * 1024; it += G * NTHR) {
        const int e8 = it & 1023, dh = (it >> 10) % 24, b = it / (24 * 1024), dir = dh / 12;
        u32x4 sc[2], sl[16]; float ac[2], al[16];
#pragma unroll
        for (int ci = 0; ci < 2; ++ci) { const int c = dir ? 1 - ci : ci; ac[ci] = AEC[(b * 2 + c) * 24 + dh]; sc[ci] = *(const u32x4*)(STC + ((size_t)(b * 2 + c) * 24 + dh) * 8192 + e8 * 8); }
#pragma unroll
        for (int ci = 0; ci < 16; ++ci) { const int c = dir ? 15 - ci : ci; al[ci] = AE[(b * 16 + c) * 24 + dh]; sl[ci] = *(const u32x4*)(ST + ((size_t)(b * 16 + c) * 24 + dh) * 8192 + e8 * 8); }
        float h[8];
#pragma unroll
        for (int e = 0; e < 8; ++e) h[e] = 0.f;
#pragma unroll
        for (int ci = 0; ci < 2; ++ci) { const float a = __expf(ac[ci]); const u32x4 s = sc[ci];
            h[0] = a * h[0] + bflo(s.x); h[1] = a * h[1] + bfhi(s.x); h[2] = a * h[2] + bflo(s.y); h[3] = a * h[3] + bfhi(s.y);
            h[4] = a * h[4] + bflo(s.z); h[5] = a * h[5] + bfhi(s.z); h[6] = a * h[6] + bflo(s.w); h[7] = a * h[7] + bfhi(s.w); }
#pragma unroll
        for (int ci = 0; ci < 16; ++ci) { const int c = dir ? 15 - ci : ci; const float a = __expf(al[ci]); const u32x4 s = sl[ci];
            u32x4 o; o.x = pk2(h[0], h[1]); o.y = pk2(h[2], h[3]); o.z = pk2(h[4], h[5]); o.w = pk2(h[6], h[7]);
            *(u32x4*)(ST + ((size_t)(b * 16 + c) * 24 + dh) * 8192 + e8 * 8) = o;
            h[0] = a * h[0] + bflo(s.x); h[1] = a * h[1] + bfhi(s.x); h[2] = a * h[2] + bflo(s.y); h[3] = a * h[3] + bfhi(s.y);
            h[4] = a * h[4] + bflo(s.z); h[5] = a * h[5] + bfhi(s.z); h[6] = a * h[6] + bflo(s.w); h[7] = a * h[7] + bfhi(s.w); }
    }
    const float* FP = (const float*)P.out; bf16_t* ACAT = (bf16_t*)(P.ws + WS_ACAT);
    for (int it = blockIdx.x * NTHR + threadIdx.x; it < 2048 * 256; it += G * NTHR) {
        const int c8 = it & 255, tp = it >> 8, col = c8 * 8, b = col >> 8, cc = col & 255;
        f32x4 s0 = (f32x4){0.f, 0.f, 0.f, 0.f}, s1 = s0;
#pragma unroll
        for (int ks = 0; ks < 3; ++ks) { const float* p = FP + ((size_t)ks * 2048 + tp) * 2048 + col; s0 += *(const f32x4*)p; s1 += *(const f32x4*)(p + 4); }
        u32x4 o; o.x = pk2(s0[0], s0[1]); o.y = pk2(s0[2], s0[3]); o.z = pk2(s1[0], s1[1]); o.w = pk2(s1[2], s1[3]);
        *(u32x4*)(ACAT + ((size_t)b * SEQ + tp) * 1024 + 768 + cc) = o; }
}

__device__ __forceinline__ void ssd_out_unit(const Params& P, ldsp lds, int u) {
    const int tid = threadIdx.x, lane = tid & 63, wave = __builtin_amdgcn_readfirstlane(tid >> 6), fr = lane & 15, fq = lane >> 4;
    const int b = u >> 6, c = (u >> 2) & 15, g = u & 3; const size_t rowbase = (size_t)b * SEQ + c * 128;
    const bf16_t* XBC = (const bf16_t*)(P.ws + WS_XBC); const float* DT = (const float*)(P.ws + WS_DT); const bf16_t* Zb = (const bf16_t*)(P.ws + WS_Z);
    const bf16_t* HIN = (const bf16_t*)(P.ws + WS_ST) + ((size_t)(b * 16 + c) * 24 + g * 3) * 8192;
    bf16_t* ACAT = (bf16_t*)(P.ws + WS_ACAT); float* SSQG = (float*)(P.ws + WS_SSQG);
    LAS bf16_t* Bs = (LAS bf16_t*)lds; LAS bf16_t* XT = (LAS bf16_t*)(lds + 34816); LAS bf16_t* HX = (LAS bf16_t*)(lds + 87040);
    LAS float* af = (LAS float*)(lds + 121856); LAS float* peb = af + 384; LAS float* dtf = peb + 384; LAS float* dtb = dtf + 384; LAS float* ef = dtb + 384; LAS float* eb = ef + 384;
    const int q = 16 * wave + fr;
    bf16x8 cfr[4];
#pragma unroll
    for (int kk = 0; kk < 4; ++kk) cfr[kk] = *(const bf16x8*)(XBC + (rowbase + q) * 1792 + 1280 + g * 128 + kk * 32 + fq * 8);
    u32x4 hreg[4];
#pragma unroll
    for (int i = 0; i < 4; ++i) { const int idx = tid + NTHR * i, dir = idx >> 10, p = (idx >> 4) & 63, c16 = idx & 15; hreg[i] = *(const u32x4*)(HIN + (size_t)(dir * 12) * 8192 + p * 128 + c16 * 8); }
    if (wave < 6) { const int r = wave % 3, dir = wave / 3, hd = dir * 12 + g * 3 + r;
        float dt0, dt1, pi0, pi1, pe0, pe1, tot;
        chunk_scan(DT, rowbase, hd, P.in[13][hd], -expf(P.in[14][hd]), lane, dt0, dt1, pi0, pi1, pe0, pe1, tot);
        const int i0 = r * 128 + 2 * lane;
        if (dir == 0) { af[i0] = pi0; af[i0 + 1] = pi1; dtf[i0] = dt0; dtf[i0 + 1] = dt1; ef[i0] = __expf(pi0); ef[i0 + 1] = __expf(pi1); }
        else { peb[i0] = pe0; peb[i0 + 1] = pe1; dtb[i0] = dt0; dtb[i0 + 1] = dt1; eb[i0] = __expf(tot - pe0); eb[i0 + 1] = __expf(tot - pe1); } }
    for (int idx = tid; idx < 2048; idx += NTHR) { const int row = idx >> 4, ch8 = idx & 15;
        *(LAS u32x4*)(Bs + row * 136 + ch8 * 8) = *(const u32x4*)(XBC + (rowbase + row) * 1792 + 768 + g * 128 + ch8 * 8); }
    load_transposed(XBC + rowbase * 1792 + g * 192, 24, XT, tid);
#pragma unroll
    for (int i = 0; i < 4; ++i) { const int idx = tid + NTHR * i, dir = idx >> 10, p = (idx >> 4) & 63, c16 = idx & 15; *(LAS u32x4*)(HX + (dir * 64 + p) * 136 + c16 * 8) = hreg[i]; }
    __syncthreads();
    f32x4 S[8];
#pragma unroll
    for (int sb = 0; sb < 8; ++sb) { S[sb] = (f32x4){0.f, 0.f, 0.f, 0.f};
#pragma unroll
        for (int kk = 0; kk < 4; ++kk) S[sb] = __builtin_amdgcn_mfma_f32_16x16x32_bf16(*(const LAS bf16x8*)(Bs + (sb * 16 + fr) * 136 + kk * 32 + fq * 8), cfr[kk], S[sb], 0, 0, 0); }
    __syncthreads();
    float ssq = 0.f;
#pragma unroll 1
    for (int r = 0; r < 3; ++r) {
        LAS bf16_t* hbuf = (r & 1) ? Bs : HX; LAS bf16_t* hnext = (r & 1) ? HX : Bs;
        if (r < 2) {
#pragma unroll
            for (int i = 0; i < 4; ++i) { const int idx = tid + NTHR * i, dir = idx >> 10, p = (idx >> 4) & 63, c16 = idx & 15; hreg[i] = *(const u32x4*)(HIN + (size_t)(dir * 12 + r + 1) * 8192 + p * 128 + c16 * 8); } }
        u32x2 xv[4], zv[4];
#pragma unroll
        for (int pb = 0; pb < 4; ++pb) { const int ch = g * 192 + r * 64 + pb * 16 + 4 * fq; xv[pb] = *(const u32x2*)(XBC + (rowbase + q) * 1792 + ch); zv[pb] = *(const u32x2*)(Zb + (rowbase + q) * 768 + ch); }
        const float afq = af[r * 128 + q], pebq = peb[r * 128 + q];
        f32x4 y[4];
#pragma unroll
        for (int pb = 0; pb < 4; ++pb) y[pb] = (f32x4){0.f, 0.f, 0.f, 0.f};
#pragma unroll
        for (int kk = 0; kk < 4; ++kk) { float mv[8];
#pragma unroll
            for (int hh = 0; hh < 2; ++hh) { const int sb = 2 * kk + hh, s0 = 16 * sb + 4 * fq;
                const f32x4 a4 = *(const LAS f32x4*)(af + r * 128 + s0), p4 = *(const LAS f32x4*)(peb + r * 128 + s0), df4 = *(const LAS f32x4*)(dtf + r * 128 + s0), db4 = *(const LAS f32x4*)(dtb + r * 128 + s0);
#pragma unroll
                for (int j = 0; j < 4; ++j) { const int s = s0 + j;
                    const float cf = (s <= q) ? __expf(afq - a4[j]) * df4[j] : 0.f, cb = (s >= q) ? __expf(p4[j] - pebq) * db4[j] : 0.f;
                    mv[hh * 4 + j] = S[sb][j] * (cf + cb); } }
            u32x4 mw; mw.x = pk2(mv[0], mv[1]); mw.y = pk2(mv[2], mv[3]); mw.z = pk2(mv[4], mv[5]); mw.w = pk2(mv[6], mv[7]);
            const bf16x8 mfr = __builtin_bit_cast(bf16x8, mw);
#pragma unroll
            for (int pb = 0; pb < 4; ++pb) { const LAS bf16_t* xp = XT + (r * 64 + pb * 16 + fr) * 136 + 32 * kk + 4 * fq;
                const u32x2 x0 = *(const LAS u32x2*)xp, x1 = *(const LAS u32x2*)(xp + 16);
                u32x4 xw; xw.x = x0.x; xw.y = x0.y; xw.z = x1.x; xw.w = x1.y;
                y[pb] = __builtin_amdgcn_mfma_f32_16x16x32_bf16(__builtin_bit_cast(bf16x8, xw), mfr, y[pb], 0, 0, 0); } }
#pragma unroll
        for (int dir = 0; dir < 2; ++dir) { const float e = dir ? eb[r * 128 + q] : ef[r * 128 + q];
#pragma unroll
            for (int pb = 0; pb < 4; ++pb) { f32x4 t = (f32x4){0.f, 0.f, 0.f, 0.f};
#pragma unroll
                for (int kk = 0; kk < 4; ++kk) t = __builtin_amdgcn_mfma_f32_16x16x32_bf16(*(const LAS bf16x8*)(hbuf + (dir * 64 + pb * 16 + fr) * 136 + kk * 32 + fq * 8), cfr[kk], t, 0, 0, 0);
                y[pb] += t * e; } }
        const float dsk = P.in[15][g * 3 + r];
#pragma unroll
        for (int pb = 0; pb < 4; ++pb) { const int ch = g * 192 + r * 64 + pb * 16 + 4 * fq;
            const float o0 = (y[pb][0] + bflo(xv[pb].x) * dsk) * silu_f(bflo(zv[pb].x)), o1 = (y[pb][1] + bfhi(xv[pb].x) * dsk) * silu_f(bfhi(zv[pb].x)),
                        o2 = (y[pb][2] + bflo(xv[pb].y) * dsk) * silu_f(bflo(zv[pb].y)), o3 = (y[pb][3] + bfhi(xv[pb].y) * dsk) * silu_f(bfhi(zv[pb].y));
            ssq += (o0 * o0 + o1 * o1) + (o2 * o2 + o3 * o3);
            u32x2 w; w.x = pk2(o0, o1); w.y = pk2(o2, o3);
            *(u32x2*)(ACAT + (rowbase + q) * 1024 + ch) = w; }
        if (r < 2) {
#pragma unroll
            for (int i = 0; i < 4; ++i) { const int idx = tid + NTHR * i, dir = idx >> 10, p = (idx >> 4) & 63, c16 = idx & 15; *(LAS u32x4*)(hnext + (dir * 64 + p) * 136 + c16 * 8) = hreg[i]; }
            __syncthreads(); }
    }
    ssq += __shfl_xor(ssq, 16); ssq += __shfl_xor(ssq, 32);
    if (fq == 0) SSQG[(rowbase + q) * 4 + g] = ssq;
    __syncthreads();
}

__device__ __forceinline__ f32x4 ld4bf(const bf16_t* p) { const u32x2 w = *(const u32x2*)p; return (f32x4){bflo(w.x), bfhi(w.x), bflo(w.y), bfhi(w.y)}; }
__device__ __forceinline__ float ssq16(const float* p) { const f32x4 a = *(const f32x4*)p, b = *(const f32x4*)(p + 4), c = *(const f32x4*)(p + 8), d = *(const f32x4*)(p + 12);
    return ((a[0] + a[1]) + (a[2] + a[3])) + ((b[0] + b[1]) + (b[2] + b[3])) + ((c[0] + c[1]) + (c[2] + c[3])) + ((d[0] + d[1]) + (d[2] + d[3])); }
__device__ __forceinline__ void p8_mid(const Params& P) {
    const int tid = threadIdx.x, lane = tid & 63, wave = tid >> 6, G = gridDim.x;
    const int gw = blockIdx.x * NWAVE + wave, NGW = G * NWAVE;
    const float* x = P.in[0]; const float* gpm = P.in[7]; const float* gpf = P.in[8]; const float* mod = (const float*)(P.ws + WS_MOD);
    const bf16_t* O1 = (const bf16_t*)(P.ws + WS_O1); const float* SSQ1 = (const float*)(P.ws + WS_SSQ1); bf16_t* H2 = (bf16_t*)(P.ws + WS_H);
    constexpr int R = 2;
    int curb = -1; f32x4 ga[4], a2[4], s2[4];
    const int UPW = (MLAT / R + NGW - 1) / NGW;
    for (int i = 0; i < UPW; ++i) { const int u = gw * UPW + i; if (u >= MLAT / R) break; const int row0 = u * R, mb = row0 >> 11;
        f32x4 xv[R][4]; u32x2 ov[R][4]; f32x4 sq[R][4];
#pragma unroll
        for (int r = 0; r < R; ++r) { const size_t ro = (size_t)(row0 + r) * DM;
#pragma unroll
            for (int j = 0; j < 4; ++j) { const int k = 4 * lane + 256 * j; xv[r][j] = *(const f32x4*)(x + ro + k); ov[r][j] = *(const u32x2*)(O1 + ro + k); sq[r][j] = *(const f32x4*)(SSQ1 + (size_t)(row0 + r) * 16 + 4 * j); } }
        if (mb != curb) { curb = mb;
#pragma unroll
            for (int j = 0; j < 4; ++j) { const int k = 4 * lane + 256 * j; const float* m = mod + mb * 6144 + k;
                ga[j] = *(const f32x4*)(m + 2048) * *(const f32x4*)(gpm + k); a2[j] = *(const f32x4*)(gpf + k) * (*(const f32x4*)(m + 4096) + 1.0f); s2[j] = *(const f32x4*)(m + 3072); } }
#pragma unroll
        for (int r = 0; r < R; ++r) { const size_t ro = (size_t)(row0 + r) * DM;
            const f32x4 q4 = (sq[r][0] + sq[r][1]) + (sq[r][2] + sq[r][3]);
            const float rstd1 = rsqrtf(((q4[0] + q4[1]) + (q4[2] + q4[3])) * (1.0f / DM) + EPS);
            f32x4 v[4]; float ss = 0.f;
#pragma unroll
            for (int j = 0; j < 4; ++j) { const int k = 4 * lane + 256 * j; const f32x4 o4 = (f32x4){bflo(ov[r][j].x), bfhi(ov[r][j].x), bflo(ov[r][j].y), bfhi(ov[r][j].y)};
                v[j] = xv[r][j] + ga[j] * o4 * rstd1; *(f32x4*)(P.out + ro + k) = v[j]; ss += (v[j][0] * v[j][0] + v[j][1] * v[j][1]) + (v[j][2] * v[j][2] + v[j][3] * v[j][3]); }
            const float rstd2 = rsqrtf(wave_sum(ss) * (1.0f / DM) + EPS);
#pragma unroll
            for (int j = 0; j < 4; ++j) { const f32x4 h = v[j] * rstd2 * a2[j] + s2[j]; u32x2 w; w.x = pk2(h[0], h[1]); w.y = pk2(h[2], h[3]);
                *(u32x2*)(H2 + ro + 4 * lane + 256 * j) = w; } }
    }
}
__device__ __forceinline__ void p11_final(const Params& P) {
    const int tid = threadIdx.x, lane = tid & 63, wave = tid >> 6, G = gridDim.x;
    const int gw = blockIdx.x * NWAVE + wave, NGW = G * NWAVE;
    const float* gpo = P.in[9]; const float* mod = (const float*)(P.ws + WS_MOD);
    const bf16_t* F2 = (const bf16_t*)(P.ws + WS_O1); const float* SSQ2 = (const float*)(P.ws + WS_SSQ2);
    constexpr int R = 4;
    int curb = -1; f32x4 ga[4];
    const int UPW = (MLAT / R + NGW - 1) / NGW;
    for (int i = 0; i < UPW; ++i) { const int u = gw * UPW + i; if (u >= MLAT / R) break; const int row0 = u * R, mb = row0 >> 11;
        f32x4 xv[R][4]; u32x2 ov[R][4]; f32x4 sq[R][4];
#pragma unroll
        for (int r = 0; r < R; ++r) { const size_t ro = (size_t)(row0 + r) * DM;
#pragma unroll
            for (int j = 0; j < 4; ++j) { const int k = 4 * lane + 256 * j; xv[r][j] = *(const f32x4*)(P.out + ro + k); ov[r][j] = *(const u32x2*)(F2 + ro + k); sq[r][j] = *(const f32x4*)(SSQ2 + (size_t)(row0 + r) * 16 + 4 * j); } }
        if (mb != curb) { curb = mb;
#pragma unroll
            for (int j = 0; j < 4; ++j) { const int k = 4 * lane + 256 * j; ga[j] = *(const f32x4*)(mod + mb * 6144 + 5120 + k) * *(const f32x4*)(gpo + k); } }
#pragma unroll
        for (int r = 0; r < R; ++r) { const size_t ro = (size_t)(row0 + r) * DM;
            const f32x4 q4 = (sq[r][0] + sq[r][1]) + (sq[r][2] + sq[r][3]);
            const float rstd = rsqrtf(((q4[0] + q4[1]) + (q4[2] + q4[3])) * (1.0f / DM) + EPS);
#pragma unroll
            for (int j = 0; j < 4; ++j) { const int k = 4 * lane + 256 * j; const f32x4 o4 = (f32x4){bflo(ov[r][j].x), bfhi(ov[r][j].x), bflo(ov[r][j].y), bfhi(ov[r][j].y)};
                *(f32x4*)(P.out + ro + k) = xv[r][j] + ga[j] * o4 * rstd; } }
    }
}

#define XB_TMO      128
#define XB_XCNT(j)  (256  + 64 * (j))
#define XB_XSUB(j)  (1280 + 64 * (j))
#define XB_XGEN(j)  (2304 + 64 * (j))
#define XB_TOP      3328
#define XB_TOPGEN   3392
#define XCD_BAR_WORDS 3456
#define XB_SPIN_CAP (1u << 18)
__device__ __forceinline__ unsigned xb_ld(unsigned* p)              { return __hip_atomic_load(p, __ATOMIC_RELAXED, __HIP_MEMORY_SCOPE_AGENT); }
__device__ __forceinline__ unsigned xb_add(unsigned* p, unsigned v) { return __hip_atomic_fetch_add(p, v, __ATOMIC_RELAXED, __HIP_MEMORY_SCOPE_AGENT); }
__device__ __forceinline__ unsigned xb_xcc_id() { return (unsigned)__builtin_amdgcn_s_getreg((3 << 11) | 20) & 0xFu; }
#define XB_SPIN(cond, bar) do { unsigned _sp = 0; while (cond) { __builtin_amdgcn_s_sleep(1); \
    if ((++_sp & 255u) == 0u) { if (xb_ld(&(bar)[XB_TMO])) break; if (_sp > XB_SPIN_CAP) { atomicAdd(&(bar)[XB_TMO], 1u); break; } } } } while (0)
struct XcdBarrier { unsigned* bar; unsigned x; volatile LAS unsigned* st; };
__device__ __forceinline__ XcdBarrier xcd_barrier_post(unsigned* bar, volatile LAS unsigned* st) {
    XcdBarrier b; b.bar = bar; b.x = xb_xcc_id(); b.st = st;
    if (threadIdx.x == 0) (void)xb_add(&bar[XB_XCNT(b.x)], 1u);
    return b;
}
__device__ __forceinline__ void xcd_barrier_complete(unsigned* bar, unsigned x, unsigned& nloc, unsigned& nx) {
    const unsigned G = gridDim.x * gridDim.y * gridDim.z;
    unsigned sum, cnt, mine, sp = 0u;
    for (;;) {
        sum = 0u; cnt = 0u; mine = 0u;
#pragma unroll
        for (unsigned j = 0; j < 16; ++j) { const unsigned c = xb_ld(&bar[XB_XCNT(j)]); sum += c; cnt += (c > 0u) ? 1u : 0u; mine = (j == x) ? c : mine; }
        if (sum == G) break;
        __builtin_amdgcn_s_sleep(1);
        if ((++sp & 255u) == 0u) { if (xb_ld(&bar[XB_TMO])) break; if (sp > XB_SPIN_CAP) { atomicAdd(&bar[XB_TMO], 1u); break; } }
    }
    nloc = mine > 0u ? mine : 1u; nx = cnt > 0u ? cnt : 1u;
}
__device__ __forceinline__ void xcd_barrier(const XcdBarrier& b) {
    asm volatile("s_waitcnt vmcnt(0)" ::: "memory");
    __syncthreads();
    if (threadIdx.x == 0) {
        unsigned* bar = b.bar;
        __builtin_amdgcn_s_waitcnt(0);
        unsigned nloc = b.st[0], nx = b.st[1];
        if (nloc == 0u) { xcd_barrier_complete(bar, b.x, nloc, nx); b.st[0] = nloc; b.st[1] = nx; }
        const unsigned old = xb_add(&bar[XB_XSUB(b.x)], 1u);
        const unsigned gen = old / nloc;
        if (old + 1u == (gen + 1u) * nloc) {
            __builtin_amdgcn_fence(__ATOMIC_RELEASE, "agent");
            asm volatile("s_waitcnt vmcnt(0)" ::: "memory");
            const unsigned og = xb_add(&bar[XB_TOP], 1u);
            const unsigned tg = og / nx;
            if (og + 1u == (tg + 1u) * nx) xb_add(&bar[XB_TOPGEN], 1u);
            else XB_SPIN(xb_ld(&bar[XB_TOPGEN]) == tg, bar);
            __builtin_amdgcn_fence(__ATOMIC_ACQUIRE, "agent");
            xb_add(&bar[XB_XGEN(b.x)], 1u);
            asm volatile("s_waitcnt vmcnt(0)" ::: "memory");
        } else {
            XB_SPIN(xb_ld(&bar[XB_XGEN(b.x)]) == gen, bar);
            __builtin_amdgcn_fence(__ATOMIC_ACQUIRE, "agent");
            asm volatile("s_waitcnt vmcnt(0)" ::: "memory");
        }
    }
    __syncthreads();
}

__global__ void __launch_bounds__(NTHR, 2) mega(Params P, int lo, int hi) {
    extern __shared__ __attribute__((aligned(16))) unsigned char lds_raw[];
    ldsp lds = (ldsp)lds_raw;
    cg::grid_group grid = cg::this_grid();
    const int G = gridDim.x;
    unsigned char* ws = P.ws;
#ifndef PH_MASK
#define PH_MASK 0xfff
#endif
#define IN(k) (((PH_MASK >> (k)) & 1) && lo <= (k) && (k) < hi)
    volatile LAS unsigned* bst = (volatile LAS unsigned*)(lds + LDS_BYTES - 16);
    if (threadIdx.x < 4) bst[threadIdx.x] = 0u;
    __syncthreads();
    (void)xcd_barrier_post((unsigned*)(ws + WS_BAR), bst);
    if (hi > 1000) grid.sync();
#define SEAM(k) do { if (IN(k) && IN((k) + 1)) { XcdBarrier xb_; xb_.bar = (unsigned*)(P.ws + WS_BAR); xb_.x = xb_xcc_id(); xb_.st = (volatile LAS unsigned*)(lds + LDS_BYTES - 16); xcd_barrier(xb_); } } while (0)
    if (IN(0)) p0_prep(P, lds);
    SEAM(0);
    if (IN(1)) p1_norm(P);
    SEAM(1);
    if (IN(2)) { pg8::Gemm g{(const bf16_t*)(ws + WS_H), (const bf16_t*)(ws + WS_W1T) + 512 * 1024, 1024, 1024, 1024, (const bf16_t*)(ws + WS_W1T), (const bf16_t*)(ws + WS_H)};
        pg8::G1Order S; S.init(G, (int)blockIdx.x);
        pg8::Epi1 E{(bf16_t*)(ws + WS_VT), (bf16_t*)(ws + WS_Z), (bf16_t*)P.out, (float*)(ws + WS_DT)};
        pg8::gemm_phase(lds, g, S, E); }
    SEAM(2);
    if (IN(3)) p3_conv(P);
    SEAM(3);
    if (IN(4)) { { pg8::Gemm g{(const bf16_t*)(ws + WS_T), (const bf16_t*)(ws + WS_VT), 4096, 4096, 1024, nullptr, nullptr}; pg8::SplitKOrder S{G, (int)blockIdx.x};
            pg8::EpiFP E{P.out}; pg8::gemm_phase(lds, g, S, E); }
        for (int u = blockIdx.x; u < 576; u += G) ssd_states_unit(P, lds, u); }
    SEAM(4);
    if (IN(5)) p5_scan(P);
    SEAM(5);
    if (IN(6)) { for (int u = blockIdx.x; u < 512; u += G) ssd_out_unit(P, lds, u); }
    SEAM(6);
    if (IN(7)) { pg8::Gemm g{(const bf16_t*)(ws + WS_ACAT), (const bf16_t*)(ws + WS_WOT), 1024, 1024, 1024, nullptr, nullptr}; pg8::StaticOrder S; S.init(MLAT, 1024, G, (int)blockIdx.x);
        pg8::EpiNorm<true> E{(bf16_t*)(ws + WS_O1), (float*)(ws + WS_SSQ1), (const float*)(ws + WS_SSQG)};
        pg8::gemm_phase(lds, g, S, E); }
    SEAM(7);
    if (IN(8)) { p8_mid(P);
        { const u32x4* wp = (const u32x4*)(ws + WS_WGUT); unsigned acc_ = 0u;
            for (int i = blockIdx.x * NTHR + threadIdx.x; i < (int)((WS_T - WS_WGUT) / 16); i += G * NTHR) { const u32x4 v = wp[i]; acc_ ^= v.x ^ v.w; }
            asm volatile("" :: "v"(acc_)); } }
    SEAM(8);
    if (IN(9)) { pg8::Gemm g{(const bf16_t*)(ws + WS_H), (const bf16_t*)(ws + WS_WGUT), 1024, 1024, 1024, nullptr, nullptr}; pg8::StaticOrder S; S.init(MLAT, 2 * DFF, G, (int)blockIdx.x);
        pg8::EpiSwiglu E{(bf16_t*)(ws + WS_G)};
        pg8::gemm_phase(lds, g, S, E); }
    SEAM(9);
    if (IN(10)) { pg8::Gemm g{(const bf16_t*)(ws + WS_G), (const bf16_t*)(ws + WS_WDT), DFF, DFF, DFF, nullptr, nullptr}; pg8::StaticOrder S; S.init(MLAT, 1024, G, (int)blockIdx.x);
        pg8::EpiNorm<false> E{(bf16_t*)(ws + WS_O1), (float*)(ws + WS_SSQ2), nullptr};
        pg8::gemm_phase(lds, g, S, E); }
    SEAM(10);
    if (IN(11)) p11_final(P);
#undef IN
#undef SEAM
}


#ifdef PROBE_K
__global__ void dump_bf16(const bf16_t* src, int pitch, int ncols, float* out) {
    for (size_t i = (size_t)blockIdx.x * blockDim.x + threadIdx.x; i < (size_t)MLAT * DM; i += (size_t)gridDim.x * blockDim.x) {
        const int row = (int)(i >> 10), c = (int)(i & 1023);
        out[i] = c < ncols ? __uint_as_float((unsigned)src[(size_t)row * pitch + c] << 16) : 0.f; }
}
#endif
extern "C" void kernel_launch(void* const* d_in, const int* in_sizes, int n_in, void* d_out, int out_size, void* d_ws, size_t ws_size, hipStream_t stream) {
    static int grid = 0;
    if (grid == 0) {
        if (n_in != 21 || out_size != MLAT * DM || ws_size < WS_END) { fprintf(stderr, "kernel_launch: unexpected shapes (n_in %d out %d ws %zu)\n", n_in, out_size, ws_size); grid = -1; return; }
        int dev = 0, cus = 0, per_cu = 0;
        hipGetDevice(&dev); hipDeviceGetAttribute(&cus, hipDeviceAttributeMultiprocessorCount, dev);
        if (hipFuncSetAttribute((const void*)mega, hipFuncAttributeMaxDynamicSharedMemorySize, LDS_BYTES) != hipSuccess) { fprintf(stderr, "kernel_launch: hipFuncSetAttribute failed\n"); grid = -1; return; }
        if (hipOccupancyMaxActiveBlocksPerMultiprocessor(&per_cu, (const void*)mega, NTHR, LDS_BYTES) != hipSuccess || per_cu < 1) { fprintf(stderr, "kernel_launch: occupancy query gave %d\n", per_cu); per_cu = 1; }
        (void)hipGetLastError();
        grid = cus * 1;
    }
    if (grid < 0) return;
    Params p{};
    for (int i = 0; i < 21; ++i) p.in[i] = (const float*)d_in[i];
    p.out = (float*)d_out; p.ws = (unsigned char*)d_ws;
#if MK_LAUNCHES == 1
    (void)hipMemsetAsync((unsigned char*)d_ws + WS_BAR, 0, XCD_BAR_WORDS * 4, stream);
    int lo = 0, hi = 12;
    void* args[] = {&p, &lo, &hi};
    hipError_t e = hipLaunchCooperativeKernel((const void*)mega, dim3(grid), dim3(NTHR), args, LDS_BYTES, stream);
    if (e != hipSuccess) fprintf(stderr, "cooperative launch failed: %s (grid %d)\n", hipGetErrorString(e), grid);
#else
#ifdef PROBE_K
    for (int ph = 0; ph <= PROBE_K; ++ph) hipLaunchKernelGGL(mega, dim3(grid), dim3(NTHR), LDS_BYTES, stream, p, ph, ph + 1);
    hipLaunchKernelGGL(dump_bf16, dim3(2048), dim3(256), 0, stream, (const bf16_t*)((unsigned char*)d_ws + PROBE_OFF), PROBE_PITCH, PROBE_NCOLS, (float*)d_out);
#else
    for (int ph = 0; ph < 12; ++ph) hipLaunchKernelGGL(mega, dim3(grid), dim3(NTHR), LDS_BYTES, stream, p, ph, ph + 1);
#endif
#endif
}
```
